# Optimizing an MI355X kernel written in HIP

```python
import math
import jax, jax.numpy as jnp
from jax import lax
import numpy as np

D_MODEL = 1024
BATCH = 16
SEQ = 2048
DEPTH = 2

GRID_W = 64
CTX_LEN = 256
EPS = 1e-6
ROPE_BASE = 10000.0
Q_BLOCK = 128
MLA_HEADS = 8
MLA_NOPE = 64
MLA_ROPE = 32
MLA_V = 64
Q_LORA = 256
KV_LORA = 128
MLA_WIDTH = MLA_HEADS * MLA_V
LRU_HEADS = 4
LRU_WIDTH = 256
LRU_BLOCK = LRU_WIDTH // LRU_HEADS
CONV_W = 4
LRU_C = 8.0
SGU_GROUPS = 4
SGU_WIDTH = 256
SGU_GROUP_DIM = SGU_WIDTH // SGU_GROUPS
CHUNK = 128
MIX_WIDTH = MLA_WIDTH + LRU_WIDTH + SGU_WIDTH
IN_SIZES = (Q_LORA, KV_LORA, MLA_ROPE, LRU_WIDTH, LRU_WIDTH, SGU_WIDTH, SGU_WIDTH)
IN_WIDTH = sum(IN_SIZES)
IN_SPLITS = tuple(int(s) for s in np.cumsum(IN_SIZES)[:-1])
D_FF_RAW = -(-8 * D_MODEL // 3)
D_FF = (D_FF_RAW + 255) // 256 * 256

kernel_name = 'hybrid_mla_rglru_sgu_dit_block'

F32 = jnp.float32


def rms_norm(x, g):
    xf = x.astype(F32)
    y = xf * lax.rsqrt(jnp.mean(xf * xf, axis=-1, keepdims=True) + EPS)
    return (y * g.astype(F32)).astype(x.dtype)


def modulate(h, shift, scale):
    return h * (1 + scale[:, None]) + shift[:, None]


def rope_2d_tables(seq_len):
    rows = seq_len // GRID_W
    row = jnp.repeat(jnp.arange(rows, dtype=F32), GRID_W)
    col = jnp.tile(jnp.arange(GRID_W, dtype=F32), rows)
    half = MLA_ROPE // 2
    freq = ROPE_BASE ** (-jnp.arange(0, half, 2, dtype=F32) / half)
    ar = row[:, None] * freq
    ac = col[:, None] * freq
    ang = jnp.concatenate([ar, ar, ac, ac], axis=-1)
    return jnp.cos(ang)[:, None, :], jnp.sin(ang)[:, None, :]


def _rot_half(v):
    v1, v2 = jnp.split(v, 2, axis=-1)
    return jnp.concatenate([-v2, v1], axis=-1)


def apply_rope_2d(x, cos, sin):
    xr, xc = jnp.split(x, 2, axis=-1)
    rotated = jnp.concatenate([_rot_half(xr), _rot_half(xc)], axis=-1)
    return x * cos.astype(x.dtype) + rotated * sin.astype(x.dtype)


def block_attention(q, k, v):
    B, S, H, dq = q.shape
    nb = S // Q_BLOCK
    qb = jnp.moveaxis(q.reshape(B, nb, Q_BLOCK, H, dq), 1, 0)
    scale = 1.0 / math.sqrt(dq)

    def one_block(qi):
        s = jnp.einsum('bqhd,bkhd->bhqk', qi, k).astype(F32) * scale
        p = jax.nn.softmax(s, axis=-1).astype(v.dtype)
        return jnp.einsum('bhqk,bkhd->bqhd', p, v)

    o = lax.map(one_block, qb)
    return jnp.moveaxis(o, 0, 1).reshape(B, S, H * v.shape[-1])


def mla_q(qa, g, w):
    B, T, _ = qa.shape
    return (rms_norm(qa, g) @ w).reshape(B, T, MLA_HEADS, MLA_NOPE + MLA_ROPE)


def mla_kv(kva, k_rope, g, w):
    B, T, _ = kva.shape
    kv = (rms_norm(kva, g) @ w).reshape(B, T, MLA_HEADS, MLA_NOPE + MLA_V)
    k_nope, v = kv[..., :MLA_NOPE], kv[..., MLA_NOPE:]
    k = jnp.concatenate([k_nope, jnp.broadcast_to(k_rope, (B, T, MLA_HEADS, MLA_ROPE))], axis=-1)
    return k, v


def short_conv(x, w, b):
    C = x.shape[-1]
    y = lax.conv_general_dilated(
        x, w[:, None, :].astype(x.dtype), window_strides=(1,),
        padding=[(CONV_W // 2, CONV_W - 1 - CONV_W // 2)],
        dimension_numbers=('NWC', 'WIO', 'NWC'), feature_group_count=C)
    return y + b


def lru_gates(xc, w_r, b_r, w_i, b_i, lam):
    B, T, C = xc.shape
    xb = xc.reshape(B, T, LRU_HEADS, LRU_BLOCK)
    r = jax.nn.sigmoid(jnp.einsum('bthi,hij->bthj', xb, w_r).reshape(B, T, C) + b_r).astype(F32)
    i = jax.nn.sigmoid(jnp.einsum('bthi,hij->bthj', xb, w_i).reshape(B, T, C) + b_i)
    log_a = -LRU_C * r * jax.nn.softplus(-lam.astype(F32))
    a = jnp.exp(log_a)
    b = jnp.sqrt(-jnp.expm1(2.0 * log_a)) * (i * xc).astype(F32)
    return a, b


def _lin_combine(left, right):
    a_l, b_l = left
    a_r, b_r = right
    return a_l * a_r, a_r * b_l + b_r


def linear_scan(a, b, h0, reverse):
    if reverse:
        a = jnp.flip(a, axis=1)
        b = jnp.flip(b, axis=1)
    b = b.at[:, 0].add(a[:, 0] * h0)
    _, h = lax.associative_scan(_lin_combine, (a, b), axis=1)
    return jnp.flip(h, axis=1) if reverse else h


def sgu(u, v, g, w_s, b_s):
    B, T, _ = u.shape
    n = T // CHUNK
    u = jax.nn.gelu(u)
    vg = jax.nn.gelu(v).reshape(B, n, CHUNK, SGU_GROUPS, SGU_GROUP_DIM)
    vg = rms_norm(vg, g.reshape(SGU_GROUPS, SGU_GROUP_DIM))
    s = jnp.einsum('gpq,bnqgc->bnpgc', w_s, vg) + b_s.T[None, None, :, :, None]
    return u * s.reshape(B, T, SGU_WIDTH)


def merge_groups(att, rec, sp, g, w_out):
    y = jnp.concatenate([
        rms_norm(att, g[:MLA_WIDTH]),
        rms_norm(rec, g[MLA_WIDTH:MLA_WIDTH + LRU_WIDTH]),
        rms_norm(sp, g[MLA_WIDTH + LRU_WIDTH:])], axis=-1)
    return y @ w_out


def token_mixers(h_l, h_c, cos, sin, w_in, q_a_norm, w_q_b, kv_a_norm, w_kv_b, conv_w, conv_b,
                 lru_w_r, lru_b_r, lru_w_i, lru_b_i, lru_lam, sgu_norm, sgu_w, sgu_b,
                 out_norm, w_out, need_ctx):
    B = h_l.shape[0]
    qa_l, kva_l, kr_l, xr_l, gr_l, su_l, sv_l = jnp.split(h_l @ w_in, IN_SPLITS, axis=-1)
    qa_c, kva_c, kr_c, xr_c, gr_c, su_c, sv_c = jnp.split(h_c @ w_in, IN_SPLITS, axis=-1)

    k_l, v_l = mla_kv(kva_l, apply_rope_2d(kr_l[:, :, None, :], cos, sin), kv_a_norm, w_kv_b)
    k_c, v_c = mla_kv(kva_c, kr_c[:, :, None, :], kv_a_norm, w_kv_b)
    q_l = mla_q(qa_l, q_a_norm, w_q_b)
    q_l = jnp.concatenate([q_l[..., :MLA_NOPE], apply_rope_2d(q_l[..., MLA_NOPE:], cos, sin)], axis=-1)
    att_l = block_attention(q_l, jnp.concatenate([k_c, k_l], axis=1), jnp.concatenate([v_c, v_l], axis=1))

    xc_l = short_conv(xr_l, conv_w, conv_b)
    xc_c = short_conv(xr_c, conv_w, conv_b)
    zero = jnp.zeros((B, LRU_WIDTH), F32)
    hsum_l = jnp.zeros(xc_l.shape, F32)
    hsum_c = jnp.zeros(xc_c.shape, F32)
    for d, rev in ((0, False), (1, True)):
        a_c, b_c = lru_gates(xc_c, lru_w_r[d], lru_b_r[d], lru_w_i[d], lru_b_i[d], lru_lam[d])
        a_l, b_l = lru_gates(xc_l, lru_w_r[d], lru_b_r[d], lru_w_i[d], lru_b_i[d], lru_lam[d])
        hc = linear_scan(a_c, b_c, zero, rev)
        seed = hc[:, 0] if rev else hc[:, -1]
        hl = linear_scan(a_l, b_l, seed, rev)
        hsum_l = hsum_l + hl
        hsum_c = hsum_c + hc
    rec_l = hsum_l.astype(h_l.dtype) * jax.nn.gelu(gr_l)

    sp_l = sgu(su_l, sv_l, sgu_norm, sgu_w, sgu_b)

    y_l = merge_groups(att_l, rec_l, sp_l, out_norm, w_out)
    if not need_ctx:
        return y_l, None
    q_c = mla_q(qa_c, q_a_norm, w_q_b)
    att_c = block_attention(q_c, k_c, v_c)
    rec_c = hsum_c.astype(h_c.dtype) * jax.nn.gelu(gr_c)
    sp_c = sgu(su_c, sv_c, sgu_norm, sgu_w, sgu_b)
    y_c = merge_groups(att_c, rec_c, sp_c, out_norm, w_out)
    return y_l, y_c


def swiglu(h, w_in, w_out):
    g, u = jnp.split(h @ w_in, 2, axis=-1)
    return (jax.nn.silu(g) * u) @ w_out


def setup_inputs(seed: int = 0) -> dict:
    key = jax.random.key(seed)
    ks = jax.random.split(key, 28)

    def nrm(k, shape, fan_in, scale=1.0):
        return scale * fan_in ** -0.5 * jax.random.normal(k, shape, F32)

    def gain(k, shape):
        return 1.0 + 0.01 * jax.random.normal(k, shape, F32)

    a0 = jax.random.uniform(ks[19], (DEPTH, 2, LRU_WIDTH), F32, 0.9, 0.999)
    s0 = a0 ** (1.0 / LRU_C)
    lam = jnp.log(s0) - jnp.log1p(-s0)
    return {
        'x': jax.random.normal(ks[0], (BATCH, SEQ, D_MODEL), F32),
        'c': jax.random.normal(ks[1], (BATCH, D_MODEL), F32),
        'ctx': jax.random.normal(ks[2], (BATCH, CTX_LEN, D_MODEL), F32),
        'c_ctx': jax.random.normal(ks[3], (D_MODEL,), F32),
        'norm1': gain(ks[4], (DEPTH, D_MODEL)),
        'norm2': gain(ks[5], (DEPTH, D_MODEL)),
        'w_ada': nrm(ks[6], (DEPTH, D_MODEL, 6 * D_MODEL), D_MODEL, 0.3),
        'b_ada': 0.01 * jax.random.normal(ks[7], (DEPTH, 6 * D_MODEL), F32),
        'w_in': nrm(ks[8], (DEPTH, D_MODEL, IN_WIDTH), D_MODEL),
        'q_a_norm': gain(ks[9], (DEPTH, Q_LORA)),
        'w_q_b': nrm(ks[10], (DEPTH, Q_LORA, MLA_HEADS * (MLA_NOPE + MLA_ROPE)), Q_LORA),
        'kv_a_norm': gain(ks[11], (DEPTH, KV_LORA)),
        'w_kv_b': nrm(ks[12], (DEPTH, KV_LORA, MLA_HEADS * (MLA_NOPE + MLA_V)), KV_LORA),
        'conv_w': nrm(ks[13], (DEPTH, CONV_W, LRU_WIDTH), CONV_W),
        'conv_b': 0.01 * jax.random.normal(ks[14], (DEPTH, LRU_WIDTH), F32),
        'lru_w_r': nrm(ks[15], (DEPTH, 2, LRU_HEADS, LRU_BLOCK, LRU_BLOCK), LRU_BLOCK),
        'lru_b_r': 0.01 * jax.random.normal(ks[16], (DEPTH, 2, LRU_WIDTH), F32),
        'lru_w_i': nrm(ks[17], (DEPTH, 2, LRU_HEADS, LRU_BLOCK, LRU_BLOCK), LRU_BLOCK),
        'lru_b_i': 0.01 * jax.random.normal(ks[18], (DEPTH, 2, LRU_WIDTH), F32),
        'lru_lam': lam,
        'sgu_norm': gain(ks[20], (DEPTH, SGU_WIDTH)),
        'sgu_w': nrm(ks[21], (DEPTH, SGU_GROUPS, CHUNK, CHUNK), CHUNK),
        'sgu_b': 1.0 + 0.01 * jax.random.normal(ks[22], (DEPTH, SGU_GROUPS, CHUNK), F32),
        'out_norm': gain(ks[23], (DEPTH, MIX_WIDTH)),
        'w_out': nrm(ks[24], (DEPTH, MIX_WIDTH, D_MODEL), MIX_WIDTH),
        'w_ffn_in': nrm(ks[25], (DEPTH, D_MODEL, 2 * D_FF), D_MODEL),
        'w_ffn_out': nrm(ks[26], (DEPTH, D_FF, D_MODEL), D_FF),
        'final_norm': gain(ks[27], (D_MODEL,)),
    }


def reference(x, c, ctx, c_ctx, norm1, norm2, w_ada, b_ada, w_in, q_a_norm, w_q_b, kv_a_norm, w_kv_b,
              conv_w, conv_b, lru_w_r, lru_b_r, lru_w_i, lru_b_i, lru_lam, sgu_norm, sgu_w, sgu_b,
              out_norm, w_out, w_ffn_in, w_ffn_out, final_norm):
    cos, sin = rope_2d_tables(x.shape[1])
    h_ctx = ctx
    for l in range(DEPTH):
        last = l == DEPTH - 1
        mod_l = jax.nn.silu(c) @ w_ada[l] + b_ada[l]
        mod_c = (jax.nn.silu(c_ctx) @ w_ada[l] + b_ada[l])[None]
        sh1, sc1, g1, sh2, sc2, g2 = jnp.split(mod_l, 6, axis=-1)
        csh1, csc1, cg1, csh2, csc2, cg2 = jnp.split(mod_c, 6, axis=-1)

        hl = modulate(rms_norm(x, norm1[l]), sh1, sc1)
        hc = modulate(rms_norm(h_ctx, norm1[l]), csh1, csc1)
        y_l, y_c = token_mixers(hl, hc, cos, sin, w_in[l], q_a_norm[l], w_q_b[l], kv_a_norm[l], w_kv_b[l],
                                conv_w[l], conv_b[l], lru_w_r[l], lru_b_r[l], lru_w_i[l], lru_b_i[l],
                                lru_lam[l], sgu_norm[l], sgu_w[l], sgu_b[l], out_norm[l], w_out[l],
                                not last)
        x = x + g1[:, None] * y_l
        x = x + g2[:, None] * swiglu(modulate(rms_norm(x, norm2[l]), sh2, sc2), w_ffn_in[l], w_ffn_out[l])
        if not last:
            h_ctx = h_ctx + cg1[:, None] * y_c
            h_ctx = h_ctx + cg2[:, None] * swiglu(modulate(rms_norm(h_ctx, norm2[l]), csh2, csc2),
                                                 w_ffn_in[l], w_ffn_out[l])
    return rms_norm(x, final_norm)
```

```cpp
#include <hip/hip_runtime.h>
#include <stdint.h>
#include <stdio.h>

constexpr int DM = 1024, NBATCH = 16, SEQ = 2048, CTXL = 256, TPB = SEQ + CTXL  , NR = NBATCH * TPB  ;
constexpr int DEPTH = 2, GRIDW = 64;
constexpr int NHEAD = 8, DNOPE = 64, DROPE = 32, DQK = 96, DV = 64, QLORA = 256, KVLORA = 128;
constexpr int LRUW = 256, SGUW = 256, CHUNK = 128;
constexpr int INW = 1440, INP = 1536;
constexpr int C_QA = 0, C_KVA = 256, C_KR = 384, C_XR = 416, C_GR = 672, C_SU = 928, C_SV = 1184;
constexpr int DFF = 2816;
constexpr int QW = NHEAD * DQK  , KVW = NHEAD * (DNOPE + DV)  ;
constexpr float EPS = 1e-6f;
constexpr int NTHR = 512;
constexpr int LDS_BYTES = 147456;

constexpr size_t MiB = 1u << 20;
constexpr size_t WS_CTL = 0, CTL_BYTES = 2 * MiB;
constexpr size_t WS_MOD = 128 * 1024;
constexpr size_t WS_SMALL = 2 * MiB;
constexpr size_t WS_ROPE = WS_SMALL;
constexpr size_t WS_RQA = WS_SMALL + 64 * 1024;
constexpr size_t WS_RKVA = WS_RQA + NR * 4;
constexpr size_t WS_AGG = WS_RKVA + NR * 4;
constexpr size_t WS_W = 4 * MiB;
constexpr size_t WSZ_WIN = (size_t)INP * DM * 2, WSZ_WQB = (size_t)QW * 256 * 2, WSZ_WKVB = (size_t)KVW * 256 * 2, WSZ_WOUT = (size_t)DM * DM * 2,
                 WSZ_WFI = (size_t)2 * DFF * DM * 2, WSZ_WFO = (size_t)DM * DFF * 2;
constexpr size_t WO_WIN = 0, WO_WQB = WO_WIN + WSZ_WIN, WO_WKVB = WO_WQB + WSZ_WQB, WO_WOUT = WO_WKVB + WSZ_WKVB, WO_WFI = WO_WOUT + WSZ_WOUT, WO_WFO = WO_WFI + WSZ_WFI,
                 WSZ_LAYER = WO_WFO + WSZ_WFO;
static_assert(WS_W + 2 * WSZ_LAYER <= 52 * MiB, "weights");
constexpr size_t WS_CRES = 52 * MiB;
constexpr size_t WS_H = 68 * MiB;
constexpr size_t WS_PROJ = 140 * MiB;
constexpr size_t WS_Q = 248 * MiB;
constexpr size_t WS_KV = 302 * MiB;
constexpr size_t WS_KROPE = 374 * MiB;
constexpr size_t WS_LRU = 377 * MiB;
constexpr size_t WS_ACT = 140 * MiB;
constexpr size_t WS_END = 449 * MiB;
static_assert(WS_ACT + (size_t)NR * DFF * 2 <= WS_KROPE, "act overlay");
static_assert(WS_LRU + (size_t)4 * NR * 256 * 2 <= WS_END, "lru");

typedef unsigned short bf16_t;
typedef float f32x4 __attribute__((ext_vector_type(4)));
typedef unsigned u32x4 __attribute__((ext_vector_type(4)));
typedef unsigned u32x2 __attribute__((ext_vector_type(2)));

struct Params {
    const float* in[28];
    float* out;
    unsigned char* ws;
};

__device__ __forceinline__ unsigned f2bf(float f) { unsigned u = __builtin_bit_cast(unsigned, f); return (u + 0x7fffu + ((u >> 16) & 1u)) >> 16; }
__device__ __forceinline__ float bf2f(unsigned h) { return __builtin_bit_cast(float, (h & 0xffffu) << 16); }
__device__ __forceinline__ unsigned pk2(float lo, float hi) { return f2bf(lo) | (f2bf(hi) << 16); }
__device__ __forceinline__ float bflo(unsigned w) { return __builtin_bit_cast(float, w << 16); }
__device__ __forceinline__ float bfhi(unsigned w) { return __builtin_bit_cast(float, w & 0xffff0000u); }
__device__ __forceinline__ float wave_sum(float v) {
#pragma unroll
    for (int o = 1; o < 64; o <<= 1) v += __shfl_xor(v, o);
    return v;
}
__device__ __forceinline__ float sigmoidf_(float x) { return 1.f / (1.f + __expf(-x)); }
__device__ __forceinline__ float siluf_(float x) { return x / (1.f + __expf(-x)); }
__device__ __forceinline__ float geluf_(float x) {
    const float u = 0.7978845608028654f * (x + 0.044715f * x * x * x);
    const float t = 1.f - 2.f / (1.f + __expf(2.f * u));
    return 0.5f * x * (1.f + t);
}
__device__ __forceinline__ float* res_row(const Params& P, int r) {
    const int b = r / TPB, t = r - b * TPB;
    return t < CTXL ? (float*)(P.ws + WS_CRES) + ((size_t)(b * CTXL + t)) * DM : P.out + ((size_t)(b * SEQ + (t - CTXL))) * DM;
}
__device__ __forceinline__ const float* modp(const Params& P, int l, int r, int chunk) {
    const int b = r / TPB, t = r - b * TPB; const int mr = t < CTXL ? 16 : b;
    return (const float*)(P.ws + WS_MOD) + ((size_t)(l * 17 + mr)) * 6144 + chunk * 1024;
}
__device__ __forceinline__ bf16_t* wptr(const Params& P, int l, size_t off) { return (bf16_t*)(P.ws + WS_W + (size_t)l * WSZ_LAYER + off); }

__device__ __forceinline__ void wprep_tile(const float* W, int K, int N, bf16_t* Wt, int KP, int kind, const float* gain, int kt, int nt, float* t  ) {
    const int tid = threadIdx.x;
    const int k0 = kt * 64, n0 = nt * 64;
    int s0;
    if (kind == 4) { const int pn = n0 / 256, half = (n0 % 256) / 128, jj = n0 % 128; s0 = half * DFF + pn * 128 + jj; } else s0 = n0;
    __syncthreads();
    for (int e = tid; e < 4096; e += NTHR) { const int i = e >> 6, j = e & 63; float v = 0.f;
        if (k0 + i < K && s0 + j < N) { v = W[(size_t)(k0 + i) * N + s0 + j]; if (gain) v *= gain[k0 + i]; }
        t[i * 65 + j] = v; }
    __syncthreads();
    for (int e = tid; e < 4096; e += NTHR) { const int j = e >> 6, i = e & 63;
        Wt[(size_t)(n0 + j) * KP + k0 + i] = (bf16_t)f2bf(t[i * 65 + j]); }
}
__device__ void stage_wprep(const Params& P, int bid, int nb, unsigned char* lds) {
    float* t = (float*)lds;
    constexpr int I0 = 16 * 24, I1 = 4 * 12, I2 = 4 * 16, I3 = 16 * 16, I4 = 16 * 88, I5 = 44 * 16, IL = I0 + I1 + I2 + I3 + I4 + I5;
    for (int it = bid; it < 2 * IL; it += nb) {
        const int l = it / IL; int r = it % IL;
        if (r < I0) { wprep_tile(P.in[8] + (size_t)l * DM * INW, DM, INW, wptr(P, l, WO_WIN), DM, 0, nullptr, r % 16, r / 16, t); continue; } r -= I0;
        if (r < I1) { wprep_tile(P.in[10] + (size_t)l * QLORA * QW, QLORA, QW, wptr(P, l, WO_WQB), 256, 1, P.in[9] + l * QLORA, r % 4, r / 4, t); continue; } r -= I1;
        if (r < I2) { wprep_tile(P.in[12] + (size_t)l * KVLORA * KVW, KVLORA, KVW, wptr(P, l, WO_WKVB), 256, 2, P.in[11] + l * KVLORA, r % 4, r / 4, t); continue; } r -= I2;
        if (r < I3) { wprep_tile(P.in[24] + (size_t)l * DM * DM, DM, DM, wptr(P, l, WO_WOUT), DM, 3, P.in[23] + l * DM, r % 16, r / 16, t); continue; } r -= I3;
        if (r < I4) { wprep_tile(P.in[25] + (size_t)l * DM * 2 * DFF, DM, 2 * DFF, wptr(P, l, WO_WFI), DM, 4, nullptr, r % 16, r / 16, t); continue; } r -= I4;
        wprep_tile(P.in[26] + (size_t)l * DFF * DM, DFF, DM, wptr(P, l, WO_WFO), DFF, 5, nullptr, r % 44, r / 44, t);
    }
}

__device__ void stage_mod(const Params& P, int bid, int nb, unsigned char* lds) {
    const int tid = threadIdx.x;
    if (bid == 0) {
        float* tab = (float*)(P.ws + WS_ROPE); const int p = tid >> 3, j = tid & 7;
        const float f = powf(10000.0f, -(float)j / 8.0f); const float a = (float)p * f;
        tab[tid] = cosf(a); tab[512 + tid] = sinf(a);
    }
    float* s = (float*)lds;
    float* red = s + 17 * 128;
    float* mod = (float*)(P.ws + WS_MOD);
    for (int it = bid; it < 2 * 96 * 8; it += nb) {
        const int l = it / 768, r = it % 768, cg = r / 8, kc = r % 8, n0 = cg * 64, k0 = kc * 128;
        __syncthreads();
        for (int e = tid; e < 17 * 128; e += NTHR) { const int i = e >> 7, k = e & 127; const float c = i < 16 ? P.in[1][i * DM + k0 + k] : P.in[3][k0 + k]; s[e] = siluf_(c); }
        __syncthreads();
        const int col = tid & 63, ks = tid >> 6;
        float acc[17];
#pragma unroll
        for (int i = 0; i < 17; ++i) acc[i] = 0.f;
        const float* w = P.in[6] + ((size_t)l * DM + k0 + ks * 16) * 6144 + n0 + col;
        for (int kk = 0; kk < 16; ++kk) { const float wv = w[(size_t)kk * 6144];
#pragma unroll
            for (int i = 0; i < 17; ++i) acc[i] += s[i * 128 + ks * 16 + kk] * wv; }
#pragma unroll
        for (int i = 0; i < 17; ++i) red[(ks * 17 + i) * 64 + col] = acc[i];
        __syncthreads();
        for (int e = tid; e < 17 * 64; e += NTHR) { const int i = e >> 6, c = e & 63; float v = 0.f;
#pragma unroll
            for (int q = 0; q < 8; ++q) v += red[(q * 17 + i) * 64 + c];
            if (kc == 0) v += P.in[7][l * 6144 + n0 + c];
            atomicAdd(mod + ((size_t)(l * 17 + i)) * 6144 + n0 + c, v); }
    }
}

__device__ void stage_norm(const Params& P, int l, int mode, int bid, int nb) {
    const int lane = threadIdx.x & 63, gw = bid * (NTHR / 64) + (threadIdx.x >> 6), ngw = nb * (NTHR / 64);
    bf16_t* H = (bf16_t*)(P.ws + WS_H);
    for (int r = gw; r < NR; r += ngw) {
        const int b = r / TPB, t = r - b * TPB; const bool isctx = t < CTXL;
        if (mode == 3 && isctx) continue;
        float* res = res_row(P, r);
        const float* src = res;
        if (mode == 0) src = isctx ? P.in[2] + ((size_t)(b * CTXL + t)) * DM : P.in[0] + ((size_t)(b * SEQ + t - CTXL)) * DM;
        f32x4 v[4]; float ss = 0.f;
#pragma unroll
        for (int j = 0; j < 4; ++j) { v[j] = *(const f32x4*)(src + j * 256 + lane * 4); ss += v[j].x * v[j].x + v[j].y * v[j].y + v[j].z * v[j].z + v[j].w * v[j].w; }
        ss = wave_sum(ss);
        const float rs = rsqrtf(ss * (1.f / DM) + EPS);
        if (mode == 0) {
#pragma unroll
            for (int j = 0; j < 4; ++j) *(f32x4*)(res + j * 256 + lane * 4) = v[j];
        }
        if (mode == 3) {
            const float* g = P.in[27];
#pragma unroll
            for (int j = 0; j < 4; ++j) { const f32x4 gv = *(const f32x4*)(g + j * 256 + lane * 4); f32x4 o = v[j] * rs * gv; *(f32x4*)(res + j * 256 + lane * 4) = o; }
            continue;
        }
        const float* g = (mode == 1 ? P.in[5] : P.in[4]) + l * DM;
        const float* sh = modp(P, l, r, mode == 1 ? 3 : 0);
        const float* sc = modp(P, l, r, mode == 1 ? 4 : 1);
#pragma unroll
        for (int j = 0; j < 4; ++j) { const int c = j * 256 + lane * 4;
            const f32x4 gv = *(const f32x4*)(g + c), shv = *(const f32x4*)(sh + c), scv = *(const f32x4*)(sc + c);
            const f32x4 y = (v[j] * rs * gv) * (1.f + scv) + shv;
            u32x2 w; w.x = pk2(y.x, y.y); w.y = pk2(y.z, y.w);
            *(u32x2*)(H + (size_t)r * DM + c) = w; }
    }
}

__device__ __forceinline__ float rope_one(const float* tab, float x, float partner, int i, int prow, int pcol) {
    const int p = (i < 16) ? prow : pcol; const float c = tab[p * 8 + (i & 7)], s = tab[512 + p * 8 + (i & 7)];
    const float rot = (i & 8) ? partner : -partner;
    return x * c + rot * s;
}
__device__ void stage_rowstat(const Params& P, int bid, int nb) {
    const int lane = threadIdx.x & 63, gw = bid * (NTHR / 64) + (threadIdx.x >> 6), ngw = nb * (NTHR / 64);
    const bf16_t* proj = (const bf16_t*)(P.ws + WS_PROJ); const float* tab = (const float*)(P.ws + WS_ROPE);
    float* rqa = (float*)(P.ws + WS_RQA); float* rkva = (float*)(P.ws + WS_RKVA); bf16_t* krope = (bf16_t*)(P.ws + WS_KROPE);
    for (int r = gw; r < NR; r += ngw) {
        const bf16_t* pr = proj + (size_t)r * INP;
        const u32x2 a = *(const u32x2*)(pr + C_QA + lane * 4); const unsigned k = *(const unsigned*)(pr + C_KVA + lane * 2);
        float s1 = bflo(a.x) * bflo(a.x) + bfhi(a.x) * bfhi(a.x) + bflo(a.y) * bflo(a.y) + bfhi(a.y) * bfhi(a.y);
        float s2 = bflo(k) * bflo(k) + bfhi(k) * bfhi(k);
        s1 = wave_sum(s1); s2 = wave_sum(s2);
        if (lane == 0) { rqa[r] = rsqrtf(s1 * (1.f / QLORA) + EPS); rkva[r] = rsqrtf(s2 * (1.f / KVLORA) + EPS); }
        const int b = r / TPB, t = r - b * TPB;
        const float x = bf2f(pr[C_KR + (lane & 31)]); const float partner = __shfl_xor(x, 8);
        float y = x;
        if (t >= CTXL) { const int pos = t - CTXL; y = rope_one(tab, x, partner, lane & 31, pos / GRIDW, pos % GRIDW); }
        if (lane < 32) krope[(size_t)r * DROPE + lane] = (bf16_t)f2bf(y);
    }
}
__device__ void stage_qrope(const Params& P, int bid, int nb) {
    const int lane = threadIdx.x & 63, gw = bid * (NTHR / 64) + (threadIdx.x >> 6), ngw = nb * (NTHR / 64);
    bf16_t* q = (bf16_t*)(P.ws + WS_Q); const float* tab = (const float*)(P.ws + WS_ROPE);
    for (int r = gw; r < NR; r += ngw) {
        const int b = r / TPB, t = r - b * TPB; if (t < CTXL) continue;
        const int pos = t - CTXL, prow = pos / GRIDW, pcol = pos % GRIDW;
#pragma unroll
        for (int j = 0; j < 4; ++j) { const int e = j * 64 + lane, h = e >> 5, i = e & 31;
            bf16_t* p = q + (size_t)r * QW + h * DQK + DNOPE + i;
            const float x = bf2f(*p); const float partner = __shfl_xor(x, 8);
            *p = (bf16_t)f2bf(rope_one(tab, x, partner, i, prow, pcol)); }
    }
}

struct RefGemm { const bf16_t* A; int lda; const bf16_t* Bt; int M, N, K; int mode; bf16_t* O; int ldc; const float* rowscale; int l, gch; };
__device__ void stage_refgemm(const Params& P, const RefGemm g, int bid, int nb, unsigned char* lds) {
    float* As = (float*)lds;
    float* Bs = As + 16 * 132;
    const int tid = threadIdx.x, tx = tid & 31, ty = tid >> 5;
    const int nM = g.M / 128, nN = g.N / 128;
    for (int it = bid; it < nM * nN; it += nb) {
        const int pm = it % nM, pn = it / nM;
        int brow0;
        float acc[8][4];
#pragma unroll
        for (int i = 0; i < 8; ++i)
#pragma unroll
            for (int j = 0; j < 4; ++j) acc[i][j] = 0.f;
        for (int k0 = 0; k0 < g.K; k0 += 16) {
            __syncthreads();
            {
                const int r = tid >> 2, kq = (tid & 3) * 4;
                const u32x2 w = *(const u32x2*)(g.A + (size_t)(pm * 128 + r) * g.lda + k0 + kq);
                As[(kq + 0) * 132 + r] = bflo(w.x); As[(kq + 1) * 132 + r] = bfhi(w.x); As[(kq + 2) * 132 + r] = bflo(w.y); As[(kq + 3) * 132 + r] = bfhi(w.y);
                int j = r;
                if (g.mode == 2) brow0 = (pn / 1) * 0 + ((pn * 64) / 128) * 256 + ((pn * 64) % 128) + (j < 64 ? j : 128 + (j - 64));
                else brow0 = pn * 128 + j;
                const u32x2 wb = *(const u32x2*)(g.Bt + (size_t)brow0 * g.K + k0 + kq);
                Bs[(kq + 0) * 132 + j] = bflo(wb.x); Bs[(kq + 1) * 132 + j] = bfhi(wb.x); Bs[(kq + 2) * 132 + j] = bflo(wb.y); Bs[(kq + 3) * 132 + j] = bfhi(wb.y);
            }
            __syncthreads();
#pragma unroll
            for (int k = 0; k < 16; ++k) {
                const f32x4 a0 = *(const f32x4*)(As + k * 132 + ty * 8), a1 = *(const f32x4*)(As + k * 132 + ty * 8 + 4);
                const f32x4 bv = *(const f32x4*)(Bs + k * 132 + tx * 4);
                const float av[8] = {a0.x, a0.y, a0.z, a0.w, a1.x, a1.y, a1.z, a1.w};
#pragma unroll
                for (int i = 0; i < 8; ++i) { acc[i][0] += av[i] * bv.x; acc[i][1] += av[i] * bv.y; acc[i][2] += av[i] * bv.z; acc[i][3] += av[i] * bv.w; }
            }
        }
        if (g.mode == 0) {
#pragma unroll
            for (int i = 0; i < 8; ++i) { const int r = pm * 128 + ty * 8 + i; const float s = g.rowscale ? g.rowscale[r] : 1.f;
                u32x2 w; w.x = pk2(acc[i][0] * s, acc[i][1] * s); w.y = pk2(acc[i][2] * s, acc[i][3] * s);
                *(u32x2*)(g.O + (size_t)r * g.ldc + pn * 128 + tx * 4) = w; }
        } else if (g.mode == 1) {
#pragma unroll
            for (int i = 0; i < 8; ++i) { const int r = pm * 128 + ty * 8 + i; float* res = res_row(P, r) + pn * 128 + tx * 4; const float* gt = modp(P, g.l, r, g.gch) + pn * 128 + tx * 4;
                f32x4 o = *(f32x4*)res; const f32x4 gv = *(const f32x4*)gt;
                o.x += gv.x * acc[i][0]; o.y += gv.y * acc[i][1]; o.z += gv.z * acc[i][2]; o.w += gv.w * acc[i][3]; *(f32x4*)res = o; }
        } else {
#pragma unroll
            for (int i = 0; i < 8; ++i) { const int r = pm * 128 + ty * 8 + i;
                float o[4];
#pragma unroll
                for (int j = 0; j < 4; ++j) { const float other = __shfl_xor(acc[i][j], 16); const float gg = tx < 16 ? acc[i][j] : other, uu = tx < 16 ? other : acc[i][j]; o[j] = siluf_(gg) * uu; }
                if (tx < 16) { u32x2 w; w.x = pk2(o[0], o[1]); w.y = pk2(o[2], o[3]); *(u32x2*)(g.O + (size_t)r * g.ldc + pn * 64 + tx * 4) = w; } }
        }
    }
}

__device__ void stage_lru_local(const Params& P, int l, int bid, int nb, unsigned char* lds) {
    const int tid = threadIdx.x, c = tid & 255, th = tid >> 8;
    float* xcT = (float*)lds;
    float* xch = xcT + 256 * 68;
    const bf16_t* proj = (const bf16_t*)(P.ws + WS_PROJ);
    bf16_t* L = (bf16_t*)(P.ws + WS_LRU); float* agg = (float*)(P.ws + WS_AGG);
    const float* cw = P.in[13] + l * 4 * LRUW; const float* cb = P.in[14] + l * LRUW;
    for (int it = bid; it < NBATCH * 36; it += nb) {
        const int b = it / 36, j = it % 36; const int t0 = j * 64;
        const int seq_lo = j < 4 ? 0 : CTXL, seq_hi = j < 4 ? CTXL : TPB;
        __syncthreads();
        {
            const float w0 = cw[c], w1 = cw[LRUW + c], w2 = cw[2 * LRUW + c], w3 = cw[3 * LRUW + c], bb = cb[c];
            const int ts = t0 + th * 32;
            auto ld = [&](int t) -> float { return (t >= seq_lo && t < seq_hi) ? bf2f(proj[(size_t)(b * TPB + t) * INP + C_XR + c]) : 0.f; };
            float xm2 = ld(ts - 2), xm1 = ld(ts - 1), x0 = ld(ts);
            for (int i = 0; i < 32; ++i) { const float xp1 = ld(ts + i + 1);
                xcT[c * 68 + th * 32 + i] = w0 * xm2 + w1 * xm1 + w2 * x0 + w3 * xp1 + bb;
                xm2 = xm1; xm1 = x0; x0 = xp1; }
        }
        __syncthreads();
        const int h = c >> 6;
#pragma unroll 1
        for (int d = 0; d < 2; ++d) {
            float ar[32], ai[32];
#pragma unroll
            for (int i = 0; i < 32; ++i) { ar[i] = 0.f; ai[i] = 0.f; }
            const float* wr = P.in[15] + ((size_t)((l * 2 + d) * 4 + h)) * 4096 + (c & 63);
            const float* wi = P.in[17] + ((size_t)((l * 2 + d) * 4 + h)) * 4096 + (c & 63);
            for (int i = 0; i < 64; ++i) { const float wrv = wr[i * 64], wiv = wi[i * 64];
                const float* xr = xcT + (h * 64 + i) * 68 + th * 32;
#pragma unroll
                for (int q = 0; q < 8; ++q) { const f32x4 x = *(const f32x4*)(xr + q * 4);
                    ar[q * 4 + 0] += x.x * wrv; ar[q * 4 + 1] += x.y * wrv; ar[q * 4 + 2] += x.z * wrv; ar[q * 4 + 3] += x.w * wrv;
                    ai[q * 4 + 0] += x.x * wiv; ai[q * 4 + 1] += x.y * wiv; ai[q * 4 + 2] += x.z * wiv; ai[q * 4 + 3] += x.w * wiv; } }
            const float br = P.in[16][(l * 2 + d) * LRUW + c], bi = P.in[18][(l * 2 + d) * LRUW + c], lam = P.in[19][(l * 2 + d) * LRUW + c];
            const float sp = (lam > 15.f) ? __expf(-lam) : log1pf(__expf(-lam));
            float hh = 0.f, pp = 1.f;
            const float m8sp = -8.f * sp;
#define LRU_STEP(i) { const float r = sigmoidf_(ar[i] + br), ig = sigmoidf_(ai[i] + bi); const float la = m8sp * r; const float a = __expf(la); \
                const float x2 = 2.f * la; const float em = -x2 * (1.f + x2 * (0.5f + x2 * (0.16666667f + x2 * (0.041666668f + x2 * (0.0083333338f + x2 * 0.0013888889f))))); \
                const float xcv = xcT[c * 68 + th * 32 + i]; const float bq = sqrtf(fmaxf(em, 0.f)) * (ig * xcv); \
                hh = a * hh + bq; pp *= a; ai[i] = hh; ar[i] = pp; __builtin_amdgcn_sched_barrier(0); }
            if (d == 0) {
#pragma unroll
                for (int i = 0; i < 32; ++i) LRU_STEP(i)
            } else {
#pragma unroll
                for (int i = 31; i >= 0; --i) LRU_STEP(i)
            }
#undef LRU_STEP
            const int first = (d == 0) ? 0 : 1;
            __syncthreads();
            if (th == first) { xch[(d * 2 + 0) * 256 + c] = pp; xch[(d * 2 + 1) * 256 + c] = hh; }
            __syncthreads();
            if (th != first) { const float A0 = xch[(d * 2 + 0) * 256 + c], B0 = xch[(d * 2 + 1) * 256 + c];
#pragma unroll
                for (int i = 0; i < 32; ++i) { ai[i] += ar[i] * B0; ar[i] *= A0; }
                const float At = (d == 0) ? ar[31] : ar[0], Bt = (d == 0) ? ai[31] : ai[0];
                float* ag = agg + ((size_t)((b * 36 + j) * 2 + d)) * 512; ag[c] = At; ag[256 + c] = Bt; }
            bf16_t* Lh = L + (size_t)(d * 2 + 0) * NR * 256; bf16_t* Lp = L + (size_t)(d * 2 + 1) * NR * 256;
            { const size_t base = (size_t)(b * TPB + t0 + th * 32) * 256 + c; bf16_t* ph = Lh + base; bf16_t* pp_ = Lp + base;
#pragma unroll
              for (int i = 0; i < 32; ++i) { ph[i * 256] = (bf16_t)f2bf(ai[i]); pp_[i * 256] = (bf16_t)f2bf(ar[i]); if ((i & 7) == 7) asm volatile("" ::: "memory"); } }
        }
    }
}

__device__ void stage_sgu(const Params& P, int l, int bid, int nb, unsigned char* lds) {
    const int tid = threadIdx.x;
    float* wT = (float*)lds;
    float* vg = wT + 128 * 132;
    const bf16_t* proj = (const bf16_t*)(P.ws + WS_PROJ); bf16_t* mix = (bf16_t*)(P.ws + WS_H);
    const int pi = tid >> 4, ci = tid & 15;
    for (int it = bid; it < NBATCH * 18; it += nb) {
        const int b = it / 18, n = it % 18; const size_t row0 = (size_t)b * TPB + n * CHUNK;
        float ssr[4] = {0.f, 0.f, 0.f, 0.f};
#pragma unroll 1
        for (int g = 0; g < 4; ++g) {
            __syncthreads();
            const float* ws_ = P.in[21] + ((size_t)(l * 4 + g)) * 16384;
#pragma unroll 4
            for (int e = tid; e < 16384; e += NTHR) { const int p = e >> 7, q = e & 127; wT[q * 132 + p] = ws_[e]; }
            { const int q = tid >> 2, c0 = (tid & 3) * 16; const bf16_t* pv = proj + (row0 + q) * INP + C_SV + g * 64 + c0;
              float v[16]; float ss = 0.f;
#pragma unroll
              for (int i = 0; i < 16; ++i) { v[i] = geluf_(bf2f(pv[i])); ss += v[i] * v[i]; }
              ss += __shfl_xor(ss, 1); ss += __shfl_xor(ss, 2);
              const float rs = rsqrtf(ss * (1.f / 64.f) + EPS); const float* gn = P.in[20] + l * SGUW + g * 64 + c0;
#pragma unroll
              for (int i = 0; i < 16; ++i) vg[q * 68 + c0 + i] = v[i] * rs * gn[i]; }
            __syncthreads();
            float acc[4][4];
#pragma unroll
            for (int i = 0; i < 4; ++i)
#pragma unroll
                for (int jx = 0; jx < 4; ++jx) acc[i][jx] = 0.f;
#pragma unroll 4
            for (int q = 0; q < 128; ++q) { const f32x4 wv = *(const f32x4*)(wT + q * 132 + pi * 4); const f32x4 xv = *(const f32x4*)(vg + q * 68 + ci * 4);
                const float wa[4] = {wv.x, wv.y, wv.z, wv.w};
#pragma unroll
                for (int i = 0; i < 4; ++i) { acc[i][0] += wa[i] * xv.x; acc[i][1] += wa[i] * xv.y; acc[i][2] += wa[i] * xv.z; acc[i][3] += wa[i] * xv.w; } }
#pragma unroll
            for (int i = 0; i < 4; ++i) { const int p = pi * 4 + i; const float bs = P.in[22][(l * 4 + g) * CHUNK + p];
                const u32x2 uw = *(const u32x2*)(proj + (row0 + p) * INP + C_SU + g * 64 + ci * 4);
                const float u[4] = {geluf_(bflo(uw.x)), geluf_(bfhi(uw.x)), geluf_(bflo(uw.y)), geluf_(bfhi(uw.y))};
                float o[4];
#pragma unroll
                for (int jx = 0; jx < 4; ++jx) { o[jx] = u[jx] * (acc[i][jx] + bs); ssr[i] += o[jx] * o[jx]; }
                u32x2 w; w.x = pk2(o[0], o[1]); w.y = pk2(o[2], o[3]);
                *(u32x2*)(mix + (row0 + p) * DM + 768 + g * 64 + ci * 4) = w; }
        }
#pragma unroll
        for (int i = 0; i < 4; ++i) { float ss = ssr[i];
            ss += __shfl_xor(ss, 1); ss += __shfl_xor(ss, 2); ss += __shfl_xor(ss, 4); ss += __shfl_xor(ss, 8);
            const float rs = rsqrtf(ss * (1.f / SGUW) + EPS);
#pragma unroll
            for (int g = 0; g < 4; ++g) { bf16_t* mp = mix + (row0 + pi * 4 + i) * DM + 768 + g * 64 + ci * 4;
                const u32x2 w0 = *(const u32x2*)mp; u32x2 w; w.x = pk2(bflo(w0.x) * rs, bfhi(w0.x) * rs); w.y = pk2(bflo(w0.y) * rs, bfhi(w0.y) * rs);
                *(u32x2*)mp = w; } }
    }
}

__device__ void stage_refattn(const Params& P, int bid, int nb, unsigned char* lds) {
    const int lane = threadIdx.x & 63, h = threadIdx.x >> 6;
    float* sc = (float*)lds + h * TPB;
    const bf16_t* Q = (const bf16_t*)(P.ws + WS_Q); const bf16_t* KV = (const bf16_t*)(P.ws + WS_KV); const bf16_t* KR = (const bf16_t*)(P.ws + WS_KROPE);
    bf16_t* mix = (bf16_t*)(P.ws + WS_H);
    const float scale = 0.10206207261596575f;
    for (int r = bid; r < NR; r += nb) {
        const int b = r / TPB, t = r - b * TPB; const int nk = t < CTXL ? CTXL : TPB;
        float q[DQK];
#pragma unroll
        for (int i = 0; i < DQK; i += 2) { const unsigned w = *(const unsigned*)(Q + (size_t)r * QW + h * DQK + i); q[i] = bflo(w); q[i + 1] = bfhi(w); }
        float mx = -1e30f;
        for (int k = lane; k < nk; k += 64) { const size_t kr = (size_t)b * TPB + k; float s = 0.f;
            const bf16_t* kp = KV + kr * KVW + h * 128;
#pragma unroll
            for (int i = 0; i < DNOPE; i += 2) { const unsigned w = *(const unsigned*)(kp + i); s += q[i] * bflo(w) + q[i + 1] * bfhi(w); }
            const bf16_t* rp = KR + kr * DROPE;
#pragma unroll
            for (int i = 0; i < DROPE; i += 2) { const unsigned w = *(const unsigned*)(rp + i); s += q[DNOPE + i] * bflo(w) + q[DNOPE + i + 1] * bfhi(w); }
            s *= scale; sc[k] = s; mx = fmaxf(mx, s); }
#pragma unroll
        for (int o = 1; o < 64; o <<= 1) mx = fmaxf(mx, __shfl_xor(mx, o));
        float sum = 0.f;
        for (int k = lane; k < nk; k += 64) { const float p = __expf(sc[k] - mx); sc[k] = p; sum += p; }
        sum = wave_sum(sum);
        float o = 0.f;
        for (int k = 0; k < nk; ++k) o += sc[k] * bf2f(KV[((size_t)b * TPB + k) * KVW + h * 128 + DNOPE + lane]);
        mix[(size_t)r * DM + h * DV + lane] = (bf16_t)f2bf(o / sum);
    }
}

__device__ void stage_finalize(const Params& P, int bid, int nb, unsigned char* lds) {
    const int tid = threadIdx.x, lane = tid & 63, wv = tid >> 6;
    float* carry = (float*)lds;
    const bf16_t* L = (const bf16_t*)(P.ws + WS_LRU); const float* agg = (const float*)(P.ws + WS_AGG);
    const bf16_t* proj = (const bf16_t*)(P.ws + WS_PROJ); bf16_t* mix = (bf16_t*)(P.ws + WS_H);
    for (int it = bid; it < NBATCH * 36; it += nb) {
        const int b = it / 36, j = it % 36;
        __syncthreads();
        { const int c = tid & 255, d = tid >> 8; float cv = 0.f;
          if (d == 0) { for (int k = 0; k < j; ++k) { const float* ag = agg + ((size_t)((b * 36 + k) * 2 + 0)) * 512; cv = ag[c] * cv + ag[256 + c]; } }
          else { if (j < 4) { for (int k = 3; k > j; --k) { const float* ag = agg + ((size_t)((b * 36 + k) * 2 + 1)) * 512; cv = ag[c] * cv + ag[256 + c]; } }
                 else { for (int k = 3; k >= 0; --k) { const float* ag = agg + ((size_t)((b * 36 + k) * 2 + 1)) * 512; cv = ag[c] * cv + ag[256 + c]; }
                        for (int k = 35; k > j; --k) { const float* ag = agg + ((size_t)((b * 36 + k) * 2 + 1)) * 512; cv = ag[c] * cv + ag[256 + c]; } } }
          carry[d * 256 + c] = cv; }
        __syncthreads();
        const f32x4 cf = *(const f32x4*)(carry + lane * 4), cr = *(const f32x4*)(carry + 256 + lane * 4);
        for (int tt = 0; tt < 8; ++tt) { const size_t row = (size_t)b * TPB + j * 64 + wv * 8 + tt;
            const u32x2 hf = *(const u32x2*)(L + (size_t)0 * NR * 256 + row * 256 + lane * 4), pf = *(const u32x2*)(L + (size_t)1 * NR * 256 + row * 256 + lane * 4);
            const u32x2 hr = *(const u32x2*)(L + (size_t)2 * NR * 256 + row * 256 + lane * 4), pr = *(const u32x2*)(L + (size_t)3 * NR * 256 + row * 256 + lane * 4);
            const u32x2 gw = *(const u32x2*)(proj + row * INP + C_GR + lane * 4);
            float v[4];
            v[0] = (bflo(hf.x) + bflo(pf.x) * cf.x + bflo(hr.x) + bflo(pr.x) * cr.x) * geluf_(bflo(gw.x));
            v[1] = (bfhi(hf.x) + bfhi(pf.x) * cf.y + bfhi(hr.x) + bfhi(pr.x) * cr.y) * geluf_(bfhi(gw.x));
            v[2] = (bflo(hf.y) + bflo(pf.y) * cf.z + bflo(hr.y) + bflo(pr.y) * cr.z) * geluf_(bflo(gw.y));
            v[3] = (bfhi(hf.y) + bfhi(pf.y) * cf.w + bfhi(hr.y) + bfhi(pr.y) * cr.w) * geluf_(bfhi(gw.y));
            float ss = wave_sum(v[0] * v[0] + v[1] * v[1] + v[2] * v[2] + v[3] * v[3]);
            const float rs = rsqrtf(ss * (1.f / LRUW) + EPS);
            u32x2 w; w.x = pk2(v[0] * rs, v[1] * rs); w.y = pk2(v[2] * rs, v[3] * rs);
            *(u32x2*)(mix + row * DM + 512 + lane * 4) = w;
            u32x4 aw = *(const u32x4*)(mix + row * DM + lane * 8);
            float a[8] = {bflo(aw.x), bfhi(aw.x), bflo(aw.y), bfhi(aw.y), bflo(aw.z), bfhi(aw.z), bflo(aw.w), bfhi(aw.w)};
            float s2 = 0.f;
#pragma unroll
            for (int i = 0; i < 8; ++i) s2 += a[i] * a[i];
            s2 = wave_sum(s2); const float r2 = rsqrtf(s2 * (1.f / 512.f) + EPS);
            aw.x = pk2(a[0] * r2, a[1] * r2); aw.y = pk2(a[2] * r2, a[3] * r2); aw.z = pk2(a[4] * r2, a[5] * r2); aw.w = pk2(a[6] * r2, a[7] * r2);
            *(u32x4*)(mix + row * DM + lane * 8) = aw; }
    }
}

enum { ST_WPREP = 0, ST_MOD, ST_NORM, ST_GEMM_IN, ST_ROWSTAT, ST_GEMM_Q, ST_GEMM_KV, ST_QROPE, ST_LRU, ST_SGU, ST_ATTN, ST_FINAL, ST_GEMM_OUT, ST_GEMM_FFI, ST_GEMM_FFO };
template <int stage> __global__ void __launch_bounds__(NTHR, 2) k_stage(Params P, int l, int mode) {
    extern __shared__ __attribute__((aligned(16))) unsigned char lds[];
    const int bid = blockIdx.x, nb = gridDim.x;
    bf16_t* H = (bf16_t*)(P.ws + WS_H); bf16_t* PROJ = (bf16_t*)(P.ws + WS_PROJ);
    switch (stage) {
    case ST_WPREP: stage_wprep(P, bid, nb, lds); break;
    case ST_MOD: stage_mod(P, bid, nb, lds); break;
    case ST_NORM: stage_norm(P, l, mode, bid, nb); break;
    case ST_GEMM_IN: { RefGemm g{H, DM, wptr(P, l, WO_WIN), NR, INP, DM, 0, PROJ, INP, nullptr, l, 0}; stage_refgemm(P, g, bid, nb, lds); } break;
    case ST_ROWSTAT: stage_rowstat(P, bid, nb); break;
    case ST_GEMM_Q: { RefGemm g{PROJ + C_QA, INP, wptr(P, l, WO_WQB), NR, QW, 256, 0, (bf16_t*)(P.ws + WS_Q), QW, (const float*)(P.ws + WS_RQA), l, 0}; stage_refgemm(P, g, bid, nb, lds); } break;
    case ST_GEMM_KV: { RefGemm g{PROJ + C_KVA, INP, wptr(P, l, WO_WKVB), NR, KVW, 256, 0, (bf16_t*)(P.ws + WS_KV), KVW, (const float*)(P.ws + WS_RKVA), l, 0}; stage_refgemm(P, g, bid, nb, lds); } break;
    case ST_QROPE: stage_qrope(P, bid, nb); break;
    case ST_LRU: stage_lru_local(P, l, bid, nb, lds); break;
    case ST_SGU: stage_sgu(P, l, bid, nb, lds); break;
    case ST_ATTN: stage_refattn(P, bid, nb, lds); break;
    case ST_FINAL: stage_finalize(P, bid, nb, lds); break;
    case ST_GEMM_OUT: { RefGemm g{H, DM, wptr(P, l, WO_WOUT), NR, DM, DM, 1, nullptr, 0, nullptr, l, 2}; stage_refgemm(P, g, bid, nb, lds); } break;
    case ST_GEMM_FFI: { RefGemm g{H, DM, wptr(P, l, WO_WFI), NR, 2 * DFF, DM, 2, (bf16_t*)(P.ws + WS_ACT), DFF, nullptr, l, 0}; stage_refgemm(P, g, bid, nb, lds); } break;
    case ST_GEMM_FFO: { RefGemm g{(bf16_t*)(P.ws + WS_ACT), DFF, wptr(P, l, WO_WFO), NR, DM, DFF, 1, nullptr, 0, nullptr, l, 5}; stage_refgemm(P, g, bid, nb, lds); } break;
    }
}

extern "C" void kernel_launch(void* const* d_in, const int* in_sizes, int n_in, void* d_out, int out_size, void* d_ws, size_t ws_size, hipStream_t stream) {
    static int ok = 0;
    if (ok == 0) {
        if (n_in != 28 || out_size != NBATCH * SEQ * DM || ws_size < WS_END) { fprintf(stderr, "kernel_launch: unexpected shapes n_in %d out %d ws %zu\n", n_in, out_size, ws_size); ok = -1; return; }
#define SETA(st) if (hipFuncSetAttribute((const void*)k_stage<st>, hipFuncAttributeMaxDynamicSharedMemorySize, LDS_BYTES) != hipSuccess) { fprintf(stderr, "hipFuncSetAttribute failed\n"); ok = -1; return; }
        SETA(ST_WPREP) SETA(ST_MOD) SETA(ST_NORM) SETA(ST_GEMM_IN) SETA(ST_ROWSTAT) SETA(ST_GEMM_Q) SETA(ST_GEMM_KV) SETA(ST_QROPE) SETA(ST_LRU) SETA(ST_SGU) SETA(ST_ATTN) SETA(ST_FINAL) SETA(ST_GEMM_OUT) SETA(ST_GEMM_FFI) SETA(ST_GEMM_FFO)
#undef SETA
        ok = 1;
    }
    if (ok < 0) return;
    Params P{};
    for (int i = 0; i < 28; ++i) P.in[i] = (const float*)d_in[i];
    P.out = (float*)d_out; P.ws = (unsigned char*)d_ws;
    (void)hipMemsetAsync((char*)d_ws + WS_CTL, 0, CTL_BYTES, stream);
    const int G = 256;
#define RUN(st, l, mode) hipLaunchKernelGGL(k_stage<st>, dim3(G), dim3(NTHR), LDS_BYTES, stream, P, (int)(l), (int)(mode))
    RUN(ST_WPREP, 0, 0); RUN(ST_MOD, 0, 0);
    RUN(ST_NORM, 0, 0);
    for (int l = 0; l < DEPTH; ++l) {
        RUN(ST_GEMM_IN, l, 0); RUN(ST_ROWSTAT, l, 0);
        RUN(ST_GEMM_Q, l, 0); RUN(ST_GEMM_KV, l, 0); RUN(ST_QROPE, l, 0);
        RUN(ST_LRU, l, 0); RUN(ST_SGU, l, 0); RUN(ST_ATTN, l, 0);
        RUN(ST_FINAL, l, 0);
        RUN(ST_GEMM_OUT, l, 0);
        RUN(ST_NORM, l, 1);
        RUN(ST_GEMM_FFI, l, 0); RUN(ST_GEMM_FFO, l, 0);
        if (l + 1 < DEPTH) RUN(ST_NORM, l + 1, 2); else RUN(ST_NORM, 0, 3);
    }
#undef RUN
}
```

```cpp
#include <hip/hip_runtime.h>
#include <stdint.h>
#include <stdio.h>

constexpr int DM = 1024, NBATCH = 16, SEQ = 2048, CTXL = 256, TPB = SEQ + CTXL  , NR = NBATCH * TPB  ;
constexpr int DEPTH = 2, GRIDW = 64;
constexpr int NHEAD = 8, DNOPE = 64, DROPE = 32, DQK = 96, DV = 64, QLORA = 256, KVLORA = 128;
constexpr int LRUW = 256, SGUW = 256, CHUNK = 128;
constexpr int INW = 1440, INP = 1536;
constexpr int C_QA = 0, C_KVA = 256, C_KR = 384, C_XR = 416, C_GR = 672, C_SU = 928, C_SV = 1184;
constexpr int DFF = 2816;
constexpr int QW = NHEAD * DQK  , KVW = NHEAD * (DNOPE + DV)  ;
constexpr float EPS = 1e-6f;
constexpr int NTHR = 512;
constexpr int LDS_BYTES = 147456;

constexpr size_t MiB = 1u << 20;
constexpr size_t WS_CTL = 0, CTL_BYTES = 2 * MiB;
constexpr size_t WS_MOD = 128 * 1024;
constexpr size_t WS_SMALL = 2 * MiB;
constexpr size_t WS_ROPE = WS_SMALL;
constexpr size_t WS_RQA = WS_SMALL + 64 * 1024;
constexpr size_t WS_RKVA = WS_RQA + NR * 4;
constexpr size_t WS_AGG = WS_RKVA + NR * 4;
constexpr size_t WS_W = 4 * MiB;
constexpr size_t WSZ_WIN = (size_t)INP * DM * 2, WSZ_WQB = (size_t)QW * 256 * 2, WSZ_WKVB = (size_t)KVW * 256 * 2, WSZ_WOUT = (size_t)DM * DM * 2,
                 WSZ_WFI = (size_t)2 * DFF * DM * 2, WSZ_WFO = (size_t)DM * DFF * 2;
constexpr size_t WO_WIN = 0, WO_WQB = WO_WIN + WSZ_WIN, WO_WKVB = WO_WQB + WSZ_WQB, WO_WOUT = WO_WKVB + WSZ_WKVB, WO_WFI = WO_WOUT + WSZ_WOUT, WO_WFO = WO_WFI + WSZ_WFI,
                 WSZ_LAYER = WO_WFO + WSZ_WFO;
static_assert(WS_W + 2 * WSZ_LAYER <= 52 * MiB, "weights");
constexpr size_t WS_CRES = 52 * MiB;
constexpr size_t WS_H = 68 * MiB;
constexpr size_t WS_PROJ = 140 * MiB;
constexpr size_t WS_Q = 248 * MiB;
constexpr size_t WS_KV = 302 * MiB;
constexpr size_t WS_KROPE = 374 * MiB;
constexpr size_t WS_LRU = 377 * MiB;
constexpr size_t WS_ACT = 140 * MiB;
constexpr size_t WS_END = 449 * MiB;
static_assert(WS_ACT + (size_t)NR * DFF * 2 <= WS_KROPE, "act overlay");
static_assert(WS_LRU + (size_t)4 * NR * 256 * 2 <= WS_END, "lru");

typedef unsigned short bf16_t;
typedef float f32x4 __attribute__((ext_vector_type(4)));
typedef unsigned u32x4 __attribute__((ext_vector_type(4)));
typedef unsigned u32x2 __attribute__((ext_vector_type(2)));

struct Params {
    const float* in[28];
    float* out;
    unsigned char* ws;
};

__device__ __forceinline__ unsigned f2bf(float f) { unsigned u = __builtin_bit_cast(unsigned, f); return (u + 0x7fffu + ((u >> 16) & 1u)) >> 16; }
__device__ __forceinline__ float bf2f(unsigned h) { return __builtin_bit_cast(float, (h & 0xffffu) << 16); }
__device__ __forceinline__ unsigned pk2(float lo, float hi) { return f2bf(lo) | (f2bf(hi) << 16); }
__device__ __forceinline__ float bflo(unsigned w) { return __builtin_bit_cast(float, w << 16); }
__device__ __forceinline__ float bfhi(unsigned w) { return __builtin_bit_cast(float, w & 0xffff0000u); }
__device__ __forceinline__ float wave_sum(float v) {
#pragma unroll
    for (int o = 1; o < 64; o <<= 1) v += __shfl_xor(v, o);
    return v;
}
__device__ __forceinline__ float sigmoidf_(float x) { return 1.f / (1.f + __expf(-x)); }
__device__ __forceinline__ float siluf_(float x) { return x / (1.f + __expf(-x)); }
__device__ __forceinline__ float geluf_(float x) {
    const float u = 0.7978845608028654f * (x + 0.044715f * x * x * x);
    const float t = 1.f - 2.f / (1.f + __expf(2.f * u));
    return 0.5f * x * (1.f + t);
}
__device__ __forceinline__ float* res_row(const Params& P, int r) {
    const int b = r / TPB, t = r - b * TPB;
    return t < CTXL ? (float*)(P.ws + WS_CRES) + ((size_t)(b * CTXL + t)) * DM : P.out + ((size_t)(b * SEQ + (t - CTXL))) * DM;
}
__device__ __forceinline__ const float* modp(const Params& P, int l, int r, int chunk) {
    const int b = r / TPB, t = r - b * TPB; const int mr = t < CTXL ? 16 : b;
    return (const float*)(P.ws + WS_MOD) + ((size_t)(l * 17 + mr)) * 6144 + chunk * 1024;
}
__device__ __forceinline__ bf16_t* wptr(const Params& P, int l, size_t off) { return (bf16_t*)(P.ws + WS_W + (size_t)l * WSZ_LAYER + off); }

__device__ __forceinline__ void wprep_tile(const float* W, int K, int N, bf16_t* Wt, int KP, int kind, const float* gain, int kt, int nt, float* t  ) {
    const int tid = threadIdx.x;
    const int k0 = kt * 64, n0 = nt * 64;
    int s0;
    if (kind == 4) { const int pn = n0 / 256, half = (n0 % 256) / 128, jj = n0 % 128; s0 = half * DFF + pn * 128 + jj; } else s0 = n0;
    __syncthreads();
    for (int e = tid; e < 4096; e += NTHR) { const int i = e >> 6, j = e & 63; float v = 0.f;
        if (k0 + i < K && s0 + j < N) { v = W[(size_t)(k0 + i) * N + s0 + j]; if (gain) v *= gain[k0 + i]; }
        t[i * 65 + j] = v; }
    __syncthreads();
    for (int e = tid; e < 4096; e += NTHR) { const int j = e >> 6, i = e & 63;
        Wt[(size_t)(n0 + j) * KP + k0 + i] = (bf16_t)f2bf(t[i * 65 + j]); }
}
__device__ void stage_wprep(const Params& P, int bid, int nb, unsigned char* lds) {
    float* t = (float*)lds;
    constexpr int I0 = 16 * 24, I1 = 4 * 12, I2 = 4 * 16, I3 = 16 * 16, I4 = 16 * 88, I5 = 44 * 16, IL = I0 + I1 + I2 + I3 + I4 + I5;
    for (int it = bid; it < 2 * IL; it += nb) {
        const int l = it / IL; int r = it % IL;
        if (r < I0) { wprep_tile(P.in[8] + (size_t)l * DM * INW, DM, INW, wptr(P, l, WO_WIN), DM, 0, nullptr, r % 16, r / 16, t); continue; } r -= I0;
        if (r < I1) { wprep_tile(P.in[10] + (size_t)l * QLORA * QW, QLORA, QW, wptr(P, l, WO_WQB), 256, 1, P.in[9] + l * QLORA, r % 4, r / 4, t); continue; } r -= I1;
        if (r < I2) { wprep_tile(P.in[12] + (size_t)l * KVLORA * KVW, KVLORA, KVW, wptr(P, l, WO_WKVB), 256, 2, P.in[11] + l * KVLORA, r % 4, r / 4, t); continue; } r -= I2;
        if (r < I3) { wprep_tile(P.in[24] + (size_t)l * DM * DM, DM, DM, wptr(P, l, WO_WOUT), DM, 3, P.in[23] + l * DM, r % 16, r / 16, t); continue; } r -= I3;
        if (r < I4) { wprep_tile(P.in[25] + (size_t)l * DM * 2 * DFF, DM, 2 * DFF, wptr(P, l, WO_WFI), DM, 4, nullptr, r % 16, r / 16, t); continue; } r -= I4;
        wprep_tile(P.in[26] + (size_t)l * DFF * DM, DFF, DM, wptr(P, l, WO_WFO), DFF, 5, nullptr, r % 44, r / 44, t);
    }
}

__device__ void stage_mod(const Params& P, int bid, int nb, unsigned char* lds) {
    const int tid = threadIdx.x;
    if (bid == 0) {
        float* tab = (float*)(P.ws + WS_ROPE); const int p = tid >> 3, j = tid & 7;
        const float f = powf(10000.0f, -(float)j / 8.0f); const float a = (float)p * f;
        tab[tid] = cosf(a); tab[512 + tid] = sinf(a);
    }
    float* s = (float*)lds;
    float* red = s + 17 * 128;
    float* mod = (float*)(P.ws + WS_MOD);
    for (int it = bid; it < 2 * 96 * 8; it += nb) {
        const int l = it / 768, r = it % 768, cg = r / 8, kc = r % 8, n0 = cg * 64, k0 = kc * 128;
        __syncthreads();
        for (int e = tid; e < 17 * 128; e += NTHR) { const int i = e >> 7, k = e & 127; const float c = i < 16 ? P.in[1][i * DM + k0 + k] : P.in[3][k0 + k]; s[e] = siluf_(c); }
        __syncthreads();
        const int col = tid & 63, ks = tid >> 6;
        float acc[17];
#pragma unroll
        for (int i = 0; i < 17; ++i) acc[i] = 0.f;
        const float* w = P.in[6] + ((size_t)l * DM + k0 + ks * 16) * 6144 + n0 + col;
        for (int kk = 0; kk < 16; ++kk) { const float wv = w[(size_t)kk * 6144];
#pragma unroll
            for (int i = 0; i < 17; ++i) acc[i] += s[i * 128 + ks * 16 + kk] * wv; }
#pragma unroll
        for (int i = 0; i < 17; ++i) red[(ks * 17 + i) * 64 + col] = acc[i];
        __syncthreads();
        for (int e = tid; e < 17 * 64; e += NTHR) { const int i = e >> 6, c = e & 63; float v = 0.f;
#pragma unroll
            for (int q = 0; q < 8; ++q) v += red[(q * 17 + i) * 64 + c];
            if (kc == 0) v += P.in[7][l * 6144 + n0 + c];
            atomicAdd(mod + ((size_t)(l * 17 + i)) * 6144 + n0 + c, v); }
    }
}

__device__ void stage_norm(const Params& P, int l, int mode, int bid, int nb) {
    const int lane = threadIdx.x & 63, gw = bid * (NTHR / 64) + (threadIdx.x >> 6), ngw = nb * (NTHR / 64);
    bf16_t* H = (bf16_t*)(P.ws + WS_H);
    for (int r = gw; r < NR; r += ngw) {
        const int b = r / TPB, t = r - b * TPB; const bool isctx = t < CTXL;
        if (mode == 3 && isctx) continue;
        float* res = res_row(P, r);
        const float* src = res;
        if (mode == 0) src = isctx ? P.in[2] + ((size_t)(b * CTXL + t)) * DM : P.in[0] + ((size_t)(b * SEQ + t - CTXL)) * DM;
        f32x4 v[4]; float ss = 0.f;
#pragma unroll
        for (int j = 0; j < 4; ++j) { v[j] = *(const f32x4*)(src + j * 256 + lane * 4); ss += v[j].x * v[j].x + v[j].y * v[j].y + v[j].z * v[j].z + v[j].w * v[j].w; }
        ss = wave_sum(ss);
        const float rs = rsqrtf(ss * (1.f / DM) + EPS);
        if (mode == 0) {
#pragma unroll
            for (int j = 0; j < 4; ++j) *(f32x4*)(res + j * 256 + lane * 4) = v[j];
        }
        if (mode == 3) {
            const float* g = P.in[27];
#pragma unroll
            for (int j = 0; j < 4; ++j) { const f32x4 gv = *(const f32x4*)(g + j * 256 + lane * 4); f32x4 o = v[j] * rs * gv; *(f32x4*)(res + j * 256 + lane * 4) = o; }
            continue;
        }
        const float* g = (mode == 1 ? P.in[5] : P.in[4]) + l * DM;
        const float* sh = modp(P, l, r, mode == 1 ? 3 : 0);
        const float* sc = modp(P, l, r, mode == 1 ? 4 : 1);
#pragma unroll
        for (int j = 0; j < 4; ++j) { const int c = j * 256 + lane * 4;
            const f32x4 gv = *(const f32x4*)(g + c), shv = *(const f32x4*)(sh + c), scv = *(const f32x4*)(sc + c);
            const f32x4 y = (v[j] * rs * gv) * (1.f + scv) + shv;
            u32x2 w; w.x = pk2(y.x, y.y); w.y = pk2(y.z, y.w);
            *(u32x2*)(H + (size_t)r * DM + c) = w; }
    }
}

__device__ __forceinline__ float rope_one(const float* tab, float x, float partner, int i, int prow, int pcol) {
    const int p = (i < 16) ? prow : pcol; const float c = tab[p * 8 + (i & 7)], s = tab[512 + p * 8 + (i & 7)];
    const float rot = (i & 8) ? partner : -partner;
    return x * c + rot * s;
}
__device__ void stage_rowstat(const Params& P, int bid, int nb) {
    const int lane = threadIdx.x & 63, gw = bid * (NTHR / 64) + (threadIdx.x >> 6), ngw = nb * (NTHR / 64);
    const bf16_t* proj = (const bf16_t*)(P.ws + WS_PROJ); const float* tab = (const float*)(P.ws + WS_ROPE);
    float* rqa = (float*)(P.ws + WS_RQA); float* rkva = (float*)(P.ws + WS_RKVA); bf16_t* krope = (bf16_t*)(P.ws + WS_KROPE);
    for (int r = gw; r < NR; r += ngw) {
        const bf16_t* pr = proj + (size_t)r * INP;
        const u32x2 a = *(const u32x2*)(pr + C_QA + lane * 4); const unsigned k = *(const unsigned*)(pr + C_KVA + lane * 2);
        float s1 = bflo(a.x) * bflo(a.x) + bfhi(a.x) * bfhi(a.x) + bflo(a.y) * bflo(a.y) + bfhi(a.y) * bfhi(a.y);
        float s2 = bflo(k) * bflo(k) + bfhi(k) * bfhi(k);
        s1 = wave_sum(s1); s2 = wave_sum(s2);
        if (lane == 0) { rqa[r] = rsqrtf(s1 * (1.f / QLORA) + EPS); rkva[r] = rsqrtf(s2 * (1.f / KVLORA) + EPS); }
        const int b = r / TPB, t = r - b * TPB;
        const float x = bf2f(pr[C_KR + (lane & 31)]); const float partner = __shfl_xor(x, 8);
        float y = x;
        if (t >= CTXL) { const int pos = t - CTXL; y = rope_one(tab, x, partner, lane & 31, pos / GRIDW, pos % GRIDW); }
        if (lane < 32) krope[(size_t)r * DROPE + lane] = (bf16_t)f2bf(y);
    }
}
__device__ void stage_qrope(const Params& P, int bid, int nb) {
    const int lane = threadIdx.x & 63, gw = bid * (NTHR / 64) + (threadIdx.x >> 6), ngw = nb * (NTHR / 64);
    bf16_t* q = (bf16_t*)(P.ws + WS_Q); const float* tab = (const float*)(P.ws + WS_ROPE);
    for (int r = gw; r < NR; r += ngw) {
        const int b = r / TPB, t = r - b * TPB; if (t < CTXL) continue;
        const int pos = t - CTXL, prow = pos / GRIDW, pcol = pos % GRIDW;
#pragma unroll
        for (int j = 0; j < 4; ++j) { const int e = j * 64 + lane, h = e >> 5, i = e & 31;
            bf16_t* p = q + (size_t)r * QW + h * DQK + DNOPE + i;
            const float x = bf2f(*p); const float partner = __shfl_xor(x, 8);
            *p = (bf16_t)f2bf(rope_one(tab, x, partner, i, prow, pcol)); }
    }
}

struct RefGemm { const bf16_t* A; int lda; const bf16_t* Bt; int M, N, K; int mode; bf16_t* O; int ldc; const float* rowscale; int l, gch; };
__device__ void stage_refgemm(const Params& P, const RefGemm g, int bid, int nb, unsigned char* lds) {
    float* As = (float*)lds;
    float* Bs = As + 16 * 132;
    const int tid = threadIdx.x, tx = tid & 31, ty = tid >> 5;
    const int nM = g.M / 128, nN = g.N / 128;
    for (int it = bid; it < nM * nN; it += nb) {
        const int pm = it % nM, pn = it / nM;
        int brow0;
        float acc[8][4];
#pragma unroll
        for (int i = 0; i < 8; ++i)
#pragma unroll
            for (int j = 0; j < 4; ++j) acc[i][j] = 0.f;
        for (int k0 = 0; k0 < g.K; k0 += 16) {
            __syncthreads();
            {
                const int r = tid >> 2, kq = (tid & 3) * 4;
                const u32x2 w = *(const u32x2*)(g.A + (size_t)(pm * 128 + r) * g.lda + k0 + kq);
                As[(kq + 0) * 132 + r] = bflo(w.x); As[(kq + 1) * 132 + r] = bfhi(w.x); As[(kq + 2) * 132 + r] = bflo(w.y); As[(kq + 3) * 132 + r] = bfhi(w.y);
                int j = r;
                if (g.mode == 2) brow0 = (pn / 1) * 0 + ((pn * 64) / 128) * 256 + ((pn * 64) % 128) + (j < 64 ? j : 128 + (j - 64));
                else brow0 = pn * 128 + j;
                const u32x2 wb = *(const u32x2*)(g.Bt + (size_t)brow0 * g.K + k0 + kq);
                Bs[(kq + 0) * 132 + j] = bflo(wb.x); Bs[(kq + 1) * 132 + j] = bfhi(wb.x); Bs[(kq + 2) * 132 + j] = bflo(wb.y); Bs[(kq + 3) * 132 + j] = bfhi(wb.y);
            }
            __syncthreads();
#pragma unroll
            for (int k = 0; k < 16; ++k) {
                const f32x4 a0 = *(const f32x4*)(As + k * 132 + ty * 8), a1 = *(const f32x4*)(As + k * 132 + ty * 8 + 4);
                const f32x4 bv = *(const f32x4*)(Bs + k * 132 + tx * 4);
                const float av[8] = {a0.x, a0.y, a0.z, a0.w, a1.x, a1.y, a1.z, a1.w};
#pragma unroll
                for (int i = 0; i < 8; ++i) { acc[i][0] += av[i] * bv.x; acc[i][1] += av[i] * bv.y; acc[i][2] += av[i] * bv.z; acc[i][3] += av[i] * bv.w; }
            }
        }
        if (g.mode == 0) {
#pragma unroll
            for (int i = 0; i < 8; ++i) { const int r = pm * 128 + ty * 8 + i; const float s = g.rowscale ? g.rowscale[r] : 1.f;
                u32x2 w; w.x = pk2(acc[i][0] * s, acc[i][1] * s); w.y = pk2(acc[i][2] * s, acc[i][3] * s);
                *(u32x2*)(g.O + (size_t)r * g.ldc + pn * 128 + tx * 4) = w; }
        } else if (g.mode == 1) {
#pragma unroll
            for (int i = 0; i < 8; ++i) { const int r = pm * 128 + ty * 8 + i; float* res = res_row(P, r) + pn * 128 + tx * 4; const float* gt = modp(P, g.l, r, g.gch) + pn * 128 + tx * 4;
                f32x4 o = *(f32x4*)res; const f32x4 gv = *(const f32x4*)gt;
                o.x += gv.x * acc[i][0]; o.y += gv.y * acc[i][1]; o.z += gv.z * acc[i][2]; o.w += gv.w * acc[i][3]; *(f32x4*)res = o; }
        } else {
#pragma unroll
            for (int i = 0; i < 8; ++i) { const int r = pm * 128 + ty * 8 + i;
                float o[4];
#pragma unroll
                for (int j = 0; j < 4; ++j) { const float other = __shfl_xor(acc[i][j], 16); const float gg = tx < 16 ? acc[i][j] : other, uu = tx < 16 ? other : acc[i][j]; o[j] = siluf_(gg) * uu; }
                if (tx < 16) { u32x2 w; w.x = pk2(o[0], o[1]); w.y = pk2(o[2], o[3]); *(u32x2*)(g.O + (size_t)r * g.ldc + pn * 64 + tx * 4) = w; } }
        }
    }
}

__device__ void stage_lru_local(const Params& P, int l, int bid, int nb, unsigned char* lds) {
    const int tid = threadIdx.x, c = tid & 255, th = tid >> 8;
    float* xcT = (float*)lds;
    float* xch = xcT + 256 * 68;
    const bf16_t* proj = (const bf16_t*)(P.ws + WS_PROJ);
    bf16_t* L = (bf16_t*)(P.ws + WS_LRU); float* agg = (float*)(P.ws + WS_AGG);
    const float* cw = P.in[13] + l * 4 * LRUW; const float* cb = P.in[14] + l * LRUW;
    for (int it = bid; it < NBATCH * 36; it += nb) {
        const int b = it / 36, j = it % 36; const int t0 = j * 64;
        const int seq_lo = j < 4 ? 0 : CTXL, seq_hi = j < 4 ? CTXL : TPB;
        __syncthreads();
        {
            const float w0 = cw[c], w1 = cw[LRUW + c], w2 = cw[2 * LRUW + c], w3 = cw[3 * LRUW + c], bb = cb[c];
            const int ts = t0 + th * 32;
            auto ld = [&](int t) -> float { return (t >= seq_lo && t < seq_hi) ? bf2f(proj[(size_t)(b * TPB + t) * INP + C_XR + c]) : 0.f; };
            float xm2 = ld(ts - 2), xm1 = ld(ts - 1), x0 = ld(ts);
            for (int i = 0; i < 32; ++i) { const float xp1 = ld(ts + i + 1);
                xcT[c * 68 + th * 32 + i] = w0 * xm2 + w1 * xm1 + w2 * x0 + w3 * xp1 + bb;
                xm2 = xm1; xm1 = x0; x0 = xp1; }
        }
        __syncthreads();
        const int h = c >> 6;
#pragma unroll 1
        for (int d = 0; d < 2; ++d) {
            float ar[32], ai[32];
#pragma unroll
            for (int i = 0; i < 32; ++i) { ar[i] = 0.f; ai[i] = 0.f; }
            const float* wr = P.in[15] + ((size_t)((l * 2 + d) * 4 + h)) * 4096 + (c & 63);
            const float* wi = P.in[17] + ((size_t)((l * 2 + d) * 4 + h)) * 4096 + (c & 63);
            for (int i = 0; i < 64; ++i) { const float wrv = wr[i * 64], wiv = wi[i * 64];
                const float* xr = xcT + (h * 64 + i) * 68 + th * 32;
#pragma unroll
                for (int q = 0; q < 8; ++q) { const f32x4 x = *(const f32x4*)(xr + q * 4);
                    ar[q * 4 + 0] += x.x * wrv; ar[q * 4 + 1] += x.y * wrv; ar[q * 4 + 2] += x.z * wrv; ar[q * 4 + 3] += x.w * wrv;
                    ai[q * 4 + 0] += x.x * wiv; ai[q * 4 + 1] += x.y * wiv; ai[q * 4 + 2] += x.z * wiv; ai[q * 4 + 3] += x.w * wiv; } }
            const float br = P.in[16][(l * 2 + d) * LRUW + c], bi = P.in[18][(l * 2 + d) * LRUW + c], lam = P.in[19][(l * 2 + d) * LRUW + c];
            const float sp = (lam > 15.f) ? __expf(-lam) : log1pf(__expf(-lam));
            float hh = 0.f, pp = 1.f;
            const float m8sp = -8.f * sp;
#define LRU_STEP(i) { const float r = sigmoidf_(ar[i] + br), ig = sigmoidf_(ai[i] + bi); const float la = m8sp * r; const float a = __expf(la); \
                const float x2 = 2.f * la; const float em = -x2 * (1.f + x2 * (0.5f + x2 * (0.16666667f + x2 * (0.041666668f + x2 * (0.0083333338f + x2 * 0.0013888889f))))); \
                const float xcv = xcT[c * 68 + th * 32 + i]; const float bq = sqrtf(fmaxf(em, 0.f)) * (ig * xcv); \
                hh = a * hh + bq; pp *= a; ai[i] = hh; ar[i] = pp; __builtin_amdgcn_sched_barrier(0); }
            if (d == 0) {
#pragma unroll
                for (int i = 0; i < 32; ++i) LRU_STEP(i)
            } else {
#pragma unroll
                for (int i = 31; i >= 0; --i) LRU_STEP(i)
            }
#undef LRU_STEP
            const int first = (d == 0) ? 0 : 1;
            __syncthreads();
            if (th == first) { xch[(d * 2 + 0) * 256 + c] = pp; xch[(d * 2 + 1) * 256 + c] = hh; }
            __syncthreads();
            if (th != first) { const float A0 = xch[(d * 2 + 0) * 256 + c], B0 = xch[(d * 2 + 1) * 256 + c];
#pragma unroll
                for (int i = 0; i < 32; ++i) { ai[i] += ar[i] * B0; ar[i] *= A0; }
                const float At = (d == 0) ? ar[31] : ar[0], Bt = (d == 0) ? ai[31] : ai[0];
                float* ag = agg + ((size_t)((b * 36 + j) * 2 + d)) * 512; ag[c] = At; ag[256 + c] = Bt; }
            bf16_t* Lh = L + (size_t)(d * 2 + 0) * NR * 256; bf16_t* Lp = L + (size_t)(d * 2 + 1) * NR * 256;
            { const size_t base = (size_t)(b * TPB + t0 + th * 32) * 256 + c; bf16_t* ph = Lh + base; bf16_t* pp_ = Lp + base;
#pragma unroll
              for (int i = 0; i < 32; ++i) { ph[i * 256] = (bf16_t)f2bf(ai[i]); pp_[i * 256] = (bf16_t)f2bf(ar[i]); if ((i & 7) == 7) asm volatile("" ::: "memory"); } }
        }
    }
}

__device__ void stage_sgu(const Params& P, int l, int bid, int nb, unsigned char* lds) {
    const int tid = threadIdx.x;
    float* wT = (float*)lds;
    float* vg = wT + 128 * 132;
    const bf16_t* proj = (const bf16_t*)(P.ws + WS_PROJ); bf16_t* mix = (bf16_t*)(P.ws + WS_H);
    const int pi = tid >> 4, ci = tid & 15;
    for (int it = bid; it < NBATCH * 18; it += nb) {
        const int b = it / 18, n = it % 18; const size_t row0 = (size_t)b * TPB + n * CHUNK;
        float ssr[4] = {0.f, 0.f, 0.f, 0.f};
#pragma unroll 1
        for (int g = 0; g < 4; ++g) {
            __syncthreads();
            const float* ws_ = P.in[21] + ((size_t)(l * 4 + g)) * 16384;
#pragma unroll 4
            for (int e = tid; e < 16384; e += NTHR) { const int p = e >> 7, q = e & 127; wT[q * 132 + p] = ws_[e]; }
            { const int q = tid >> 2, c0 = (tid & 3) * 16; const bf16_t* pv = proj + (row0 + q) * INP + C_SV + g * 64 + c0;
              float v[16]; float ss = 0.f;
#pragma unroll
              for (int i = 0; i < 16; ++i) { v[i] = geluf_(bf2f(pv[i])); ss += v[i] * v[i]; }
              ss += __shfl_xor(ss, 1); ss += __shfl_xor(ss, 2);
              const float rs = rsqrtf(ss * (1.f / 64.f) + EPS); const float* gn = P.in[20] + l * SGUW + g * 64 + c0;
#pragma unroll
              for (int i = 0; i < 16; ++i) vg[q * 68 + c0 + i] = v[i] * rs * gn[i]; }
            __syncthreads();
            float acc[4][4];
#pragma unroll
            for (int i = 0; i < 4; ++i)
#pragma unroll
                for (int jx = 0; jx < 4; ++jx) acc[i][jx] = 0.f;
#pragma unroll 4
            for (int q = 0; q < 128; ++q) { const f32x4 wv = *(const f32x4*)(wT + q * 132 + pi * 4); const f32x4 xv = *(const f32x4*)(vg + q * 68 + ci * 4);
                const float wa[4] = {wv.x, wv.y, wv.z, wv.w};
#pragma unroll
                for (int i = 0; i < 4; ++i) { acc[i][0] += wa[i] * xv.x; acc[i][1] += wa[i] * xv.y; acc[i][2] += wa[i] * xv.z; acc[i][3] += wa[i] * xv.w; } }
#pragma unroll
            for (int i = 0; i < 4; ++i) { const int p = pi * 4 + i; const float bs = P.in[22][(l * 4 + g) * CHUNK + p];
                const u32x2 uw = *(const u32x2*)(proj + (row0 + p) * INP + C_SU + g * 64 + ci * 4);
                const float u[4] = {geluf_(bflo(uw.x)), geluf_(bfhi(uw.x)), geluf_(bflo(uw.y)), geluf_(bfhi(uw.y))};
                float o[4];
#pragma unroll
                for (int jx = 0; jx < 4; ++jx) { o[jx] = u[jx] * (acc[i][jx] + bs); ssr[i] += o[jx] * o[jx]; }
                u32x2 w; w.x = pk2(o[0], o[1]); w.y = pk2(o[2], o[3]);
                *(u32x2*)(mix + (row0 + p) * DM + 768 + g * 64 + ci * 4) = w; }
        }
#pragma unroll
        for (int i = 0; i < 4; ++i) { float ss = ssr[i];
            ss += __shfl_xor(ss, 1); ss += __shfl_xor(ss, 2); ss += __shfl_xor(ss, 4); ss += __shfl_xor(ss, 8);
            const float rs = rsqrtf(ss * (1.f / SGUW) + EPS);
#pragma unroll
            for (int g = 0; g < 4; ++g) { bf16_t* mp = mix + (row0 + pi * 4 + i) * DM + 768 + g * 64 + ci * 4;
                const u32x2 w0 = *(const u32x2*)mp; u32x2 w; w.x = pk2(bflo(w0.x) * rs, bfhi(w0.x) * rs); w.y = pk2(bflo(w0.y) * rs, bfhi(w0.y) * rs);
                *(u32x2*)mp = w; } }
    }
}

__device__ void stage_refattn(const Params& P, int bid, int nb, unsigned char* lds) {
    const int lane = threadIdx.x & 63, h = threadIdx.x >> 6;
    float* sc = (float*)lds + h * TPB;
    const bf16_t* Q = (const bf16_t*)(P.ws + WS_Q); const bf16_t* KV = (const bf16_t*)(P.ws + WS_KV); const bf16_t* KR = (const bf16_t*)(P.ws + WS_KROPE);
    bf16_t* mix = (bf16_t*)(P.ws + WS_H);
    const float scale = 0.10206207261596575f;
    for (int r = bid; r < NR; r += nb) {
        const int b = r / TPB, t = r - b * TPB; const int nk = t < CTXL ? CTXL : TPB;
        float q[DQK];
#pragma unroll
        for (int i = 0; i < DQK; i += 2) { const unsigned w = *(const unsigned*)(Q + (size_t)r * QW + h * DQK + i); q[i] = bflo(w); q[i + 1] = bfhi(w); }
        float mx = -1e30f;
        for (int k = lane; k < nk; k += 64) { const size_t kr = (size_t)b * TPB + k; float s = 0.f;
            const bf16_t* kp = KV + kr * KVW + h * 128;
#pragma unroll
            for (int i = 0; i < DNOPE; i += 2) { const unsigned w = *(const unsigned*)(kp + i); s += q[i] * bflo(w) + q[i + 1] * bfhi(w); }
            const bf16_t* rp = KR + kr * DROPE;
#pragma unroll
            for (int i = 0; i < DROPE; i += 2) { const unsigned w = *(const unsigned*)(rp + i); s += q[DNOPE + i] * bflo(w) + q[DNOPE + i + 1] * bfhi(w); }
            s *= scale; sc[k] = s; mx = fmaxf(mx, s); }
#pragma unroll
        for (int o = 1; o < 64; o <<= 1) mx = fmaxf(mx, __shfl_xor(mx, o));
        float sum = 0.f;
        for (int k = lane; k < nk; k += 64) { const float p = __expf(sc[k] - mx); sc[k] = p; sum += p; }
        sum = wave_sum(sum);
        float o = 0.f;
        for (int k = 0; k < nk; ++k) o += sc[k] * bf2f(KV[((size_t)b * TPB + k) * KVW + h * 128 + DNOPE + lane]);
        mix[(size_t)r * DM + h * DV + lane] = (bf16_t)f2bf(o / sum);
    }
}

__device__ void stage_finalize(const Params& P, int bid, int nb, unsigned char* lds) {
    const int tid = threadIdx.x, lane = tid & 63, wv = tid >> 6;
    float* carry = (float*)lds;
    const bf16_t* L = (const bf16_t*)(P.ws + WS_LRU); const float* agg = (const float*)(P.ws + WS_AGG);
    const bf16_t* proj = (const bf16_t*)(P.ws + WS_PROJ); bf16_t* mix = (bf16_t*)(P.ws + WS_H);
    for (int it = bid; it < NBATCH * 36; it += nb) {
        const int b = it / 36, j = it % 36;
        __syncthreads();
        { const int c = tid & 255, d = tid >> 8; float cv = 0.f;
          if (d == 0) { for (int k = 0; k < j; ++k) { const float* ag = agg + ((size_t)((b * 36 + k) * 2 + 0)) * 512; cv = ag[c] * cv + ag[256 + c]; } }
          else { if (j < 4) { for (int k = 3; k > j; --k) { const float* ag = agg + ((size_t)((b * 36 + k) * 2 + 1)) * 512; cv = ag[c] * cv + ag[256 + c]; } }
                 else { for (int k = 3; k >= 0; --k) { const float* ag = agg + ((size_t)((b * 36 + k) * 2 + 1)) * 512; cv = ag[c] * cv + ag[256 + c]; }
                        for (int k = 35; k > j; --k) { const float* ag = agg + ((size_t)((b * 36 + k) * 2 + 1)) * 512; cv = ag[c] * cv + ag[256 + c]; } } }
          carry[d * 256 + c] = cv; }
        __syncthreads();
        const f32x4 cf = *(const f32x4*)(carry + lane * 4), cr = *(const f32x4*)(carry + 256 + lane * 4);
        for (int tt = 0; tt < 8; ++tt) { const size_t row = (size_t)b * TPB + j * 64 + wv * 8 + tt;
            const u32x2 hf = *(const u32x2*)(L + (size_t)0 * NR * 256 + row * 256 + lane * 4), pf = *(const u32x2*)(L + (size_t)1 * NR * 256 + row * 256 + lane * 4);
            const u32x2 hr = *(const u32x2*)(L + (size_t)2 * NR * 256 + row * 256 + lane * 4), pr = *(const u32x2*)(L + (size_t)3 * NR * 256 + row * 256 + lane * 4);
            const u32x2 gw = *(const u32x2*)(proj + row * INP + C_GR + lane * 4);
            float v[4];
            v[0] = (bflo(hf.x) + bflo(pf.x) * cf.x + bflo(hr.x) + bflo(pr.x) * cr.x) * geluf_(bflo(gw.x));
            v[1] = (bfhi(hf.x) + bfhi(pf.x) * cf.y + bfhi(hr.x) + bfhi(pr.x) * cr.y) * geluf_(bfhi(gw.x));
            v[2] = (bflo(hf.y) + bflo(pf.y) * cf.z + bflo(hr.y) + bflo(pr.y) * cr.z) * geluf_(bflo(gw.y));
            v[3] = (bfhi(hf.y) + bfhi(pf.y) * cf.w + bfhi(hr.y) + bfhi(pr.y) * cr.w) * geluf_(bfhi(gw.y));
            float ss = wave_sum(v[0] * v[0] + v[1] * v[1] + v[2] * v[2] + v[3] * v[3]);
            const float rs = rsqrtf(ss * (1.f / LRUW) + EPS);
            u32x2 w; w.x = pk2(v[0] * rs, v[1] * rs); w.y = pk2(v[2] * rs, v[3] * rs);
            *(u32x2*)(mix + row * DM + 512 + lane * 4) = w;
            u32x4 aw = *(const u32x4*)(mix + row * DM + lane * 8);
            float a[8] = {bflo(aw.x), bfhi(aw.x), bflo(aw.y), bfhi(aw.y), bflo(aw.z), bfhi(aw.z), bflo(aw.w), bfhi(aw.w)};
            float s2 = 0.f;
#pragma unroll
            for (int i = 0; i < 8; ++i) s2 += a[i] * a[i];
            s2 = wave_sum(s2); const float r2 = rsqrtf(s2 * (1.f / 512.f) + EPS);
            aw.x = pk2(a[0] * r2, a[1] * r2); aw.y = pk2(a[2] * r2, a[3] * r2); aw.z = pk2(a[4] * r2, a[5] * r2); aw.w = pk2(a[6] * r2, a[7] * r2);
            *(u32x4*)(mix + row * DM + lane * 8) = aw; }
    }
}


namespace pg8 {
#define PG8_LAS __attribute__((address_space(3)))
typedef unsigned short bf16_t;
typedef short bf16x8 __attribute__((ext_vector_type(8)));
typedef float f32x4 __attribute__((ext_vector_type(4)));
typedef unsigned u32x4 __attribute__((ext_vector_type(4)));
constexpr int BM = 256, BK = 64, HALF = 128, HTB = HALF * BK * 2  , STAGE_BYTES = 8 * HTB, NXCD = 8, WGM = 8;

__host__ __device__ __forceinline__ int lds_byte(int r, int c) { const int st = (r >> 4) * 2 + (c >> 5), rr = r & 15, cc = c & 31, ob = rr * 64 + cc * 2; return st * 1024 + (ob ^ (((ob >> 9) & 1) << 5)); }
__host__ __device__ __forceinline__ void stage_rc(int b, int& R, int& C) { const int st = b / 1024, sb = b % 1024, swz = sb ^ (((sb >> 9) & 1) << 5); R = (st >> 1) * 16 + swz / 64; C = (st & 1) * 32 + (swz % 64) / 2; }
__host__ __device__ __forceinline__ int perm32(int rho) { const int n = rho >> 4, i = rho & 15; return 8 * (i >> 2) + 4 * n + (i & 3); }

struct Unit { int pm, pn; };
struct Gemm { const bf16_t* A; const bf16_t* Bt; int M, N, K, lda; };

struct StaticOrder {
    int nM, nN, nwg, G, c;
    __host__ __device__ void init(int M, int N, int G_, int c_) { nM = M / BM; nN = N / BM; nwg = nM * nN; G = G_; c = c_; }
    __host__ __device__ bool next(int i, Unit& u) const {
        const long L = (long)i * G + c; if (L >= nwg) return false;
        int wgid = (int)L; { const int q = nwg / NXCD, r = nwg % NXCD, xcd = wgid % NXCD, off = wgid / NXCD; wgid = (xcd < r ? xcd * (q + 1) : r * (q + 1) + (xcd - r) * q) + off; }
        const int nig = WGM * nN, gid = wgid / nig, fm = gid * WGM, gsz = (nM - fm) < WGM ? (nM - fm) : WGM;
        u.pm = fm + ((wgid % nig) % gsz); u.pn = (wgid % nig) / gsz; return true;
    }
    __device__ __forceinline__ void a_ready(const Unit&) const {}
    __device__ __forceinline__ void done(const Unit&) const {}
};

template <class Epi, class Sched, bool ALIGN_EPI = false, bool SP2 = false>
__device__ __forceinline__ void gemm_phase(PG8_LAS unsigned char* lds, const Gemm g, const Sched& S, const Epi& E) {
    const int tid = threadIdx.x, wid = __builtin_amdgcn_readfirstlane(tid >> 6), lane = tid & 63, wr = wid >> 2, wc = wid & 3, fr = lane & 15, fq = lane >> 4;
    const int K = g.K, nt = K / BK;
    unsigned voffA[2], voffB[2];
#pragma unroll
    for (int i = 0; i < 2; ++i) { int R, C; stage_rc(tid * 16 + i * 8192, R, C); const int Rb = Epi::PERM ? ((R & ~31) + perm32(R & 31)) : R;
        voffA[i] = (unsigned)(R * g.lda + C) * 2u; voffB[i] = (unsigned)(Rb * K + C) * 2u; }
    const size_t kstep = (size_t)(BK * 2);
    const size_t hstepA = (size_t)HALF * g.lda * 2, hstepB = (size_t)HALF * K * 2;
    const size_t tstepA = 2 * hstepA, tstepB = 2 * hstepB;
    const unsigned ldsw = (unsigned)wid * 1024u;
    const int aoff = lds_byte(wr * 64 + fr, fq * 8), boff = lds_byte(wc * 32 + fr, fq * 8);
#define PG8_SA(b, h) (((b) * 2 + (h)) * HTB)
#define PG8_SB(b, h) ((4 + (b) * 2 + (h)) * HTB)
#define PG8_STAGE(bufoff, gbase, voff) do { _Pragma("unroll") for (int _i = 0; _i < 2; ++_i) \
        __builtin_amdgcn_global_load_lds((const unsigned*)((const char*)(gbase) + (voff)[_i]), (PG8_LAS unsigned*)(lds + (bufoff) + ldsw + _i * 8192), 16, 0, 0); } while (0)
#define PG8_LDA(dst, b, h) do { _Pragma("unroll") for (int m = 0; m < 4; ++m) _Pragma("unroll") for (int k = 0; k < 2; ++k) dst[m][k] = *(const PG8_LAS bf16x8*)(lds + PG8_SA(b, h) + aoff + m * 2048 + k * 1024); } while (0)
#define PG8_LDB(dst, b, h) do { _Pragma("unroll") for (int n = 0; n < 2; ++n) _Pragma("unroll") for (int k = 0; k < 2; ++k) dst[n][k] = *(const PG8_LAS bf16x8*)(lds + PG8_SB(b, h) + boff + n * 2048 + k * 1024); } while (0)
#define PG8_MMA(ai, bj, At, Bt) do { __builtin_amdgcn_s_setprio(1); _Pragma("unroll") for (int m = 0; m < 4; ++m) _Pragma("unroll") for (int n = 0; n < 2; ++n) _Pragma("unroll") for (int k = 0; k < 2; ++k) \
        acc[ai][bj][m][n] = __builtin_amdgcn_mfma_f32_16x16x32_bf16(Bt[n][k], At[m][k], acc[ai][bj][m][n], 0, 0, 0); __builtin_amdgcn_s_setprio(0); } while (0)
#define PG8_WAIT_V(n) asm volatile("s_waitcnt vmcnt(" #n ")" ::: "memory")
#define PG8_WAIT_L(n) asm volatile("s_waitcnt lgkmcnt(" #n ")" ::: "memory")
#define PG8_BAR __builtin_amdgcn_s_barrier()
#define PG8_SCHED __builtin_amdgcn_sched_barrier(0)
    Unit cur, nxt; int ui = 0;
    if (!S.next(0, cur)) return;
    f32x4 acc[2][2][4][2];
#pragma unroll
    for (int a = 0; a < 2; ++a)
#pragma unroll
        for (int b = 0; b < 2; ++b)
#pragma unroll
            for (int m = 0; m < 4; ++m)
#pragma unroll
                for (int n = 0; n < 2; ++n) acc[a][b][m][n] = (f32x4){0.f, 0.f, 0.f, 0.f};
    bf16x8 At[4][2], B0[2][2], B1[2][2];
    const char* cA = (const char*)g.A + (size_t)cur.pm * tstepA; const char* cB = (const char*)g.Bt + (size_t)cur.pn * tstepB;
    S.a_ready(cur);
    if constexpr (SP2) {
        PG8_STAGE(PG8_SB(0, 0), cB, voffB); PG8_STAGE(PG8_SB(0, 1), cB + hstepB, voffB); PG8_STAGE(PG8_SA(0, 0), cA, voffA); PG8_STAGE(PG8_SA(0, 1), cA + hstepA, voffA);
        if (wr == 1) PG8_BAR;
        PG8_WAIT_V(2); PG8_BAR;
        PG8_STAGE(PG8_SB(1, 0), cB + kstep, voffB); PG8_STAGE(PG8_SA(1, 0), cA + kstep, voffA); PG8_STAGE(PG8_SB(1, 1), cB + hstepB + kstep, voffB);
        PG8_WAIT_V(6); PG8_BAR;
    } else {
        PG8_STAGE(PG8_SB(0, 0), cB, voffB); PG8_STAGE(PG8_SA(0, 0), cA, voffA); PG8_STAGE(PG8_SB(0, 1), cB + hstepB, voffB); PG8_STAGE(PG8_SA(0, 1), cA + hstepA, voffA);
        if (wr == 1) PG8_BAR;
        PG8_WAIT_V(4); PG8_BAR;
        PG8_STAGE(PG8_SB(1, 0), cB + kstep, voffB); PG8_STAGE(PG8_SA(1, 0), cA + kstep, voffA); PG8_STAGE(PG8_SB(1, 1), cB + hstepB + kstep, voffB);
        PG8_WAIT_V(6); PG8_BAR;
    }
    for (;;) {
        const bool has_next = S.next(ui + 1, nxt);
        const char* nA = has_next ? (const char*)g.A + (size_t)nxt.pm * tstepA : cA; const char* nB = has_next ? (const char*)g.Bt + (size_t)nxt.pn * tstepB : cB;
        for (int t = 0; t < nt; t += 2) {
            const bool last = (t == nt - 2);
            const char* a1 = cA + (size_t)(t + 1) * kstep;
            const char* a2 = last ? nA : cA + (size_t)(t + 2) * kstep; const char* b2 = last ? nB : cB + (size_t)(t + 2) * kstep;
            const char* a3 = a2 + kstep; const char* b3 = b2 + kstep;
            if (last && has_next) S.a_ready(nxt);
            if constexpr (SP2) {
            PG8_LDB(B0, 0, 0); PG8_LDB(B1, 0, 1); PG8_SCHED; PG8_LDA(At, 0, 0); PG8_STAGE(PG8_SA(1, 1), a1 + hstepA, voffA);
            PG8_WAIT_V(8); PG8_WAIT_L(0); PG8_BAR; PG8_MMA(0, 0, At, B0); PG8_MMA(0, 1, At, B1); PG8_BAR; PG8_SCHED;
            PG8_LDA(At, 0, 1); PG8_STAGE(PG8_SB(0, 0), b2, voffB); PG8_STAGE(PG8_SB(0, 1), b2 + hstepB, voffB); PG8_STAGE(PG8_SA(0, 0), a2, voffA);
            PG8_WAIT_V(8); PG8_WAIT_L(0); PG8_BAR; PG8_MMA(1, 0, At, B0); PG8_MMA(1, 1, At, B1); PG8_BAR; PG8_SCHED;
            PG8_LDB(B0, 1, 0); PG8_LDB(B1, 1, 1); PG8_SCHED; PG8_LDA(At, 1, 0); PG8_STAGE(PG8_SA(0, 1), a2 + hstepA, voffA);
            PG8_WAIT_V(8); PG8_WAIT_L(0); PG8_BAR; PG8_MMA(0, 0, At, B0); PG8_MMA(0, 1, At, B1); PG8_BAR; PG8_SCHED;
            PG8_LDA(At, 1, 1); PG8_STAGE(PG8_SB(1, 0), b3, voffB); PG8_STAGE(PG8_SB(1, 1), b3 + hstepB, voffB); PG8_STAGE(PG8_SA(1, 0), a3, voffA);
            PG8_WAIT_V(8); PG8_WAIT_L(0); PG8_BAR; PG8_MMA(1, 0, At, B0); PG8_MMA(1, 1, At, B1); PG8_BAR; PG8_SCHED;
            } else {
            PG8_LDB(B0, 0, 0); PG8_SCHED; PG8_LDA(At, 0, 0); PG8_STAGE(PG8_SA(1, 1), a1 + hstepA, voffA);
            PG8_WAIT_L(8); PG8_BAR; PG8_WAIT_L(0); PG8_MMA(0, 0, At, B0); PG8_BAR; PG8_SCHED;
            PG8_LDB(B1, 0, 1); PG8_STAGE(PG8_SB(0, 0), b2, voffB);
            PG8_BAR; PG8_WAIT_L(0); PG8_MMA(0, 1, At, B1); PG8_BAR;
            PG8_LDA(At, 0, 1); PG8_STAGE(PG8_SA(0, 0), a2, voffA);
            PG8_BAR; PG8_WAIT_L(0); PG8_MMA(1, 0, At, B0); PG8_BAR; PG8_SCHED;
            PG8_STAGE(PG8_SB(0, 1), b2 + hstepB, voffB);
            PG8_WAIT_V(6); PG8_BAR; PG8_MMA(1, 1, At, B1); PG8_BAR;
            PG8_LDB(B0, 1, 0); PG8_SCHED; PG8_LDA(At, 1, 0); PG8_STAGE(PG8_SA(0, 1), a2 + hstepA, voffA);
            PG8_WAIT_L(8); PG8_BAR; PG8_WAIT_L(0); PG8_MMA(0, 0, At, B0); PG8_BAR; PG8_SCHED;
            PG8_LDB(B1, 1, 1); PG8_STAGE(PG8_SB(1, 0), b3, voffB);
            PG8_BAR; PG8_WAIT_L(0); PG8_MMA(0, 1, At, B1); PG8_BAR;
            PG8_LDA(At, 1, 1); PG8_STAGE(PG8_SA(1, 0), a3, voffA);
            PG8_BAR; PG8_WAIT_L(0); PG8_MMA(1, 0, At, B0); PG8_BAR; PG8_SCHED;
            PG8_STAGE(PG8_SB(1, 1), b3 + hstepB, voffB);
            PG8_WAIT_V(6); PG8_BAR; PG8_MMA(1, 1, At, B1); PG8_BAR;
            }
        }
        if constexpr (ALIGN_EPI) { if (wr == 0) PG8_BAR; }
        if constexpr (!Epi::AFTER_DRAIN) { E(acc, cur, wr, wc, fr, fq); S.done(cur); }
        if (!has_next) break;
#pragma unroll
        for (int a = 0; a < 2; ++a)
#pragma unroll
            for (int b = 0; b < 2; ++b)
#pragma unroll
                for (int m = 0; m < 4; ++m)
#pragma unroll
                    for (int n = 0; n < 2; ++n) acc[a][b][m][n] = (f32x4){0.f, 0.f, 0.f, 0.f};
        cur = nxt; cA = nA; cB = nB; ++ui;
        if constexpr (ALIGN_EPI) { if (wr == 1) PG8_BAR; }
    }
    PG8_WAIT_V(0);
    if constexpr (!ALIGN_EPI) { if (wr == 0) PG8_BAR; }
    PG8_BAR;
    if constexpr (Epi::AFTER_DRAIN) { E.fused(acc, cur, wr, wc, fr, fq, lds, wid, lane); S.done(cur); }
#undef PG8_SA
#undef PG8_SB
#undef PG8_STAGE
#undef PG8_LDA
#undef PG8_LDB
#undef PG8_MMA
#undef PG8_WAIT_V
#undef PG8_WAIT_L
#undef PG8_BAR
#undef PG8_SCHED
}
}

using pg8::Unit;
__device__ __forceinline__ unsigned cvt_pk_bf16(float lo, float hi) { unsigned r; asm volatile("v_cvt_pk_bf16_f32 %0, %1, %2" : "=v"(r) : "v"(lo), "v"(hi)); return r; }
struct EpiBf16S {
    static constexpr bool PERM = true, AFTER_DRAIN = false;
    bf16_t* O; int ldc; const float* rowscale;
    __device__ __forceinline__ void operator()(const pg8::f32x4 (&acc)[2][2][4][2], const Unit& u, int wr, int wc, int fr, int fq) const {
        const int row0 = u.pm * 256 + wr * 64 + fr, col0 = u.pn * 256 + wc * 32 + 8 * fq;
#pragma unroll
        for (int ai = 0; ai < 2; ++ai)
#pragma unroll
            for (int m = 0; m < 4; ++m) { const int r = row0 + ai * 128 + m * 16; const float s = rowscale ? rowscale[r] : 1.f; bf16_t* rowp = O + (size_t)r * ldc + col0;
#pragma unroll
                for (int bj = 0; bj < 2; ++bj) { const pg8::f32x4 v0 = acc[ai][bj][m][0] * s, v1 = acc[ai][bj][m][1] * s;
                    u32x4 w; w.x = cvt_pk_bf16(v0[0], v0[1]); w.y = cvt_pk_bf16(v0[2], v0[3]); w.z = cvt_pk_bf16(v1[0], v1[1]); w.w = cvt_pk_bf16(v1[2], v1[3]);
                    *(u32x4*)(rowp + bj * 128) = w; } }
    }
};
struct EpiRes {
    static constexpr bool PERM = false, AFTER_DRAIN = false;
    float* out; unsigned char* ws; int l, gch;
    __device__ __forceinline__ void operator()(const pg8::f32x4 (&acc)[2][2][4][2], const Unit& u, int wr, int wc, int fr, int fq) const {
        const int b = u.pm / 9, j = u.pm - b * 9; const bool isctx = (j == 0);
        float* res0 = isctx ? (float*)(ws + WS_CRES) + (size_t)(b * CTXL) * DM : out + (size_t)(b * SEQ + (j - 1) * 256) * DM;
        const float* gate = (const float*)(ws + WS_MOD) + ((size_t)(l * 17 + (isctx ? 16 : b))) * 6144 + gch * 1024;
        const int col0 = u.pn * 256 + wc * 32 + 4 * fq;
        pg8::f32x4 gv[2][2];
#pragma unroll
        for (int bj = 0; bj < 2; ++bj)
#pragma unroll
            for (int n = 0; n < 2; ++n) gv[bj][n] = *(const pg8::f32x4*)(gate + col0 + bj * 128 + n * 16);
#pragma unroll
        for (int ai = 0; ai < 2; ++ai)
#pragma unroll
            for (int m = 0; m < 4; ++m) { float* p = res0 + (size_t)(wr * 64 + fr + ai * 128 + m * 16) * DM + col0;
#pragma unroll
                for (int bj = 0; bj < 2; ++bj)
#pragma unroll
                    for (int n = 0; n < 2; ++n) { pg8::f32x4 o = *(const pg8::f32x4*)(p + bj * 128 + n * 16); o += gv[bj][n] * acc[ai][bj][m][n]; *(pg8::f32x4*)(p + bj * 128 + n * 16) = o; } }
    }
};
struct EpiSwiglu {
    static constexpr bool PERM = true, AFTER_DRAIN = false;
    bf16_t* O; int ldc;
    __device__ __forceinline__ void operator()(const pg8::f32x4 (&acc)[2][2][4][2], const Unit& u, int wr, int wc, int fr, int fq) const {
        const int row0 = u.pm * 256 + wr * 64 + fr, col0 = u.pn * 128 + wc * 32 + 8 * fq;
#pragma unroll
        for (int ai = 0; ai < 2; ++ai)
#pragma unroll
            for (int m = 0; m < 4; ++m) { bf16_t* rowp = O + (size_t)(row0 + ai * 128 + m * 16) * ldc + col0; float o[8];
#pragma unroll
                for (int n = 0; n < 2; ++n)
#pragma unroll
                    for (int i = 0; i < 4; ++i) { const float g = acc[ai][0][m][n][i], uu = acc[ai][1][m][n][i]; o[n * 4 + i] = g * uu * __builtin_amdgcn_rcpf(1.f + __expf(-g)); }
                u32x4 w; w.x = cvt_pk_bf16(o[0], o[1]); w.y = cvt_pk_bf16(o[2], o[3]); w.z = cvt_pk_bf16(o[4], o[5]); w.w = cvt_pk_bf16(o[6], o[7]);
                *(u32x4*)rowp = w; }
    }
};

namespace attn {
using bf16x8 = __attribute__((ext_vector_type(8))) short;
using s16x4  = __attribute__((ext_vector_type(4))) short;
using f32x16 = __attribute__((ext_vector_type(16))) float;
constexpr int NW = 8, QBLK = 32, KVBLK = 64;
constexpr float SCALE = 0.10206207261596575f;
constexpr float THR = 8.f;
constexpr int SHM_K = 64 * 256, SHM_V = 64 * 64 * 2, SHM_ATTN = 2 * SHM_V + 2 * SHM_K + NW * 64 * 4;
#define KSWZ(row, colB) ((row) * 256 + ((colB) ^ (((row) & 7) << 4)))
#define SBAR() __builtin_amdgcn_sched_barrier(0)
__device__ __forceinline__ int crow(int r, int hi) { return (r & 3) + 8 * (r >> 2) + 4 * hi; }
__device__ __forceinline__ unsigned cvtpk(float lo, float hi) { unsigned r; asm volatile("v_cvt_pk_bf16_f32 %0, %1, %2" : "=v"(r) : "v"(lo), "v"(hi)); return r; }
__device__ __forceinline__ void partialSM(f32x16& p0, f32x16& p1, float& m_reg, float& mn, float& alpha) {
  constexpr float C = SCALE * 1.4426950408889634f;
  float pmax = p0[0];
#pragma unroll
  for (int r = 1; r < 16; ++r) pmax = fmaxf(pmax, p0[r]);
#pragma unroll
  for (int r = 0; r < 16; ++r) pmax = fmaxf(pmax, p1[r]);
  { auto rr = __builtin_amdgcn_permlane32_swap(__float_as_uint(pmax), __float_as_uint(pmax), false, false);
    pmax = fmaxf(__uint_as_float(rr[0]), __uint_as_float(rr[1])); }
  if (__builtin_expect(__all(pmax - m_reg <= THR / SCALE), 1)) { mn = m_reg; alpha = 1.f; }
  else { mn = fmaxf(m_reg, pmax); alpha = __builtin_amdgcn_exp2f((m_reg - mn) * C); m_reg = mn; }
  float mnC = -mn * C;
#pragma unroll
  for (int r = 0; r < 16; ++r) p0[r] = fmaf(p0[r], C, mnC);
#pragma unroll
  for (int r = 0; r < 16; ++r) p1[r] = fmaf(p1[r], C, mnC);
#pragma unroll
  for (int r = 0; r < 16; ++r) p0[r] = __builtin_amdgcn_exp2f(p0[r]);
}
__device__ __forceinline__ void finishSM(f32x16& p0, f32x16& p1, float alpha, float& l_reg, bf16x8& pa0, bf16x8& pa1, bf16x8& pa2, bf16x8& pa3) {
#pragma unroll
  for (int r = 0; r < 16; ++r) p1[r] = __builtin_amdgcn_exp2f(p1[r]);
  float ps = 0;
#pragma unroll
  for (int r = 0; r < 16; ++r) ps += p0[r];
#pragma unroll
  for (int r = 0; r < 16; ++r) ps += p1[r];
  { auto rr = __builtin_amdgcn_permlane32_swap(__float_as_uint(ps), __float_as_uint(ps), false, false);
    ps = __uint_as_float(rr[0]) + __uint_as_float(rr[1]); }
  l_reg = l_reg * alpha + ps;
#define PK4(P, BASE, OUT) do { unsigned a0 = cvtpk(P[BASE + 0], P[BASE + 1]), a1 = cvtpk(P[BASE + 2], P[BASE + 3]);   \
    unsigned b0 = cvtpk(P[BASE + 4], P[BASE + 5]), b1 = cvtpk(P[BASE + 6], P[BASE + 7]);                              \
    auto r0 = __builtin_amdgcn_permlane32_swap(a0, b0, false, false); auto r1 = __builtin_amdgcn_permlane32_swap(a1, b1, false, false); \
    u32x4 w = {r0[0], r1[0], r0[1], r1[1]}; OUT = *reinterpret_cast<bf16x8*>(&w); } while (0)
  PK4(p0, 0, pa0); PK4(p0, 8, pa1); PK4(p1, 0, pa2); PK4(p1, 8, pa3);
#undef PK4
}
__device__ __forceinline__ void qkt(f32x16& p0, f32x16& p1, const char* Ks, const bf16x8* qr, int r32, int hi) {
  p0 = f32x16{}; p1 = f32x16{};
#pragma unroll
  for (int d0 = 0; d0 < 6; ++d0) { int cb = (d0 * 16 + hi * 8) * 2;
    bf16x8 b0 = *reinterpret_cast<const bf16x8*>(Ks + KSWZ(r32, cb));
    bf16x8 b1 = *reinterpret_cast<const bf16x8*>(Ks + KSWZ(32 + r32, cb));
    p0 = __builtin_amdgcn_mfma_f32_32x32x16_bf16(b0, qr[d0], p0, 0, 0, 0);
    p1 = __builtin_amdgcn_mfma_f32_32x32x16_bf16(b1, qr[d0], p1, 0, 0, 0); }
}
__device__ __forceinline__ int v_st(int k, int c) { const int kk = (k & ~0xC) | ((k & 4) << 1) | ((k & 8) >> 1); return ((kk >> 3) * 2 + (c >> 5)) * 512 + ((kk & 7) * 32 + (c & 31)) * 2; }
__device__ __forceinline__ int v_rd_base(int lane) { return ((lane & 3) << 3) | (((lane >> 2) & 3) << 6) | (((lane >> 4) & 1) << 5) | (((lane >> 5) & 1) << 8); }
constexpr int v_rd_off(int d0, int ks, int half) { return d0 * 512 + ks * 2048 + half * 1024; }
template <int OFF> __device__ __forceinline__ s16x4 tr_read(int vb) {
  s16x4 r; asm volatile("ds_read_b64_tr_b16 %0, %1 offset:%2" : "=&v"(r) : "v"(vb), "i"(OFF) : "memory"); return r;
}
template <int D0> __device__ __forceinline__ void pv_one(f32x16& od, int vb, bf16x8 pa0, bf16x8 pa1, bf16x8 pa2, bf16x8 pa3) {
  const s16x4 l0 = tr_read<v_rd_off(D0, 0, 0)>(vb), h0 = tr_read<v_rd_off(D0, 0, 1)>(vb), l1 = tr_read<v_rd_off(D0, 1, 0)>(vb), h1 = tr_read<v_rd_off(D0, 1, 1)>(vb);
  const s16x4 l2 = tr_read<v_rd_off(D0, 2, 0)>(vb), h2 = tr_read<v_rd_off(D0, 2, 1)>(vb), l3 = tr_read<v_rd_off(D0, 3, 0)>(vb), h3 = tr_read<v_rd_off(D0, 3, 1)>(vb);
  asm volatile("s_waitcnt lgkmcnt(0)" ::: "memory"); SBAR();
#define PK(L, H) (bf16x8){L[0], L[1], L[2], L[3], H[0], H[1], H[2], H[3]}
  od = __builtin_amdgcn_mfma_f32_32x32x16_bf16(pa0, PK(l0, h0), od, 0, 0, 0);
  od = __builtin_amdgcn_mfma_f32_32x32x16_bf16(pa1, PK(l1, h1), od, 0, 0, 0);
  od = __builtin_amdgcn_mfma_f32_32x32x16_bf16(pa2, PK(l2, h2), od, 0, 0, 0);
  od = __builtin_amdgcn_mfma_f32_32x32x16_bf16(pa3, PK(l3, h3), od, 0, 0, 0);
#undef PK
}
__device__ __forceinline__ void pv_d0(f32x16* o, int vb, bf16x8 pa0, bf16x8 pa1, bf16x8 pa2, bf16x8 pa3) {
  pv_one<0>(o[0], vb, pa0, pa1, pa2, pa3); pv_one<1>(o[1], vb, pa0, pa1, pa2, pa3);
}
__device__ __forceinline__ void attn_unit(const bf16_t* __restrict__ Qb, const bf16_t* __restrict__ KVb, const bf16_t* __restrict__ KRb, bf16_t* __restrict__ Ob, int seq, char* lds) {
  const int tid = threadIdx.x, wid = tid >> 6, lane = tid & 63, r32 = lane & 31, hi = lane >> 5;
  char* V_lds = lds; char* K_lds = lds + 2 * SHM_V;
  float* ws = (float*)(lds + 2 * SHM_V + 2 * SHM_K) + wid * 64; float* li_l = ws; float* al_l = ws + 32;
  float m_reg = -1e30f, l_reg = 0; f32x16 o[2] = {}; bf16x8 qr[6];
  const bf16_t* Qw = Qb + (long)(wid * QBLK + r32) * QW + hi * 8;
#pragma unroll
  for (int d0 = 0; d0 < 6; ++d0) qr[d0] = *reinterpret_cast<const bf16x8*>(Qw + d0 * 16);
  const int sr = tid >> 4, c16 = tid & 15;
  const bool kfromkv = c16 < 8; const int kc = c16 < 12 ? c16 : 8;
  const bf16_t* kp0 = kfromkv ? KVb + (long)sr * KVW + kc * 8 : KRb + (long)sr * DROPE + (kc - 8) * 8;
  const long kstr = kfromkv ? KVW : DROPE;
  const bf16_t* vp0 = KVb + (long)sr * KVW + DNOPE + (c16 & 7) * 8;
  const int vst0 = v_st(sr, (c16 & 7) * 8), vst1 = v_st(32 + sr, (c16 & 7) * 8);
  const int kst0 = KSWZ(sr, kc * 16), kst1 = KSWZ(32 + sr, kc * 16);
  const bool kwr = c16 < 12, vwr = c16 < 8;
  const int vb0 = (int)(uintptr_t)V_lds + v_rd_base(lane);
  struct { bf16x8 vs0, vs1, ks0, ks1; } sr_[2];
#define SLOAD(i, k0) do { sr_[i].vs0 = *reinterpret_cast<const bf16x8*>(vp0 + (long)(k0) * KVW); sr_[i].vs1 = *reinterpret_cast<const bf16x8*>(vp0 + (long)((k0) + 32) * KVW); \
    sr_[i].ks0 = *reinterpret_cast<const bf16x8*>(kp0 + (long)(k0) * kstr); sr_[i].ks1 = *reinterpret_cast<const bf16x8*>(kp0 + (long)((k0) + 32) * kstr); } while (0)
#define SWRITE(b, i) do { if (vwr) { *(bf16x8*)(V_lds + (b) * SHM_V + vst0) = sr_[i].vs0; *(bf16x8*)(V_lds + (b) * SHM_V + vst1) = sr_[i].vs1; } \
    if (kwr) { *(bf16x8*)(K_lds + (b) * SHM_K + kst0) = sr_[i].ks0; *(bf16x8*)(K_lds + (b) * SHM_K + kst1) = sr_[i].ks1; } } while (0)
#define SWAIT() asm volatile("s_waitcnt vmcnt(4)" ::: "memory")
#define RESC(a) do { if (__any((a) < 1.f)) { if (hi == 0) al_l[r32] = (a); asm volatile("s_waitcnt lgkmcnt(0)" ::: "memory"); \
    _Pragma("unroll") for (int d = 0; d < 2; ++d) _Pragma("unroll") for (int r = 0; r < 16; ++r) o[d][r] *= al_l[crow(r, hi)]; } } while (0)
  f32x16 pA0, pA1, pB0, pB1; float mnA, mnB, alA, alB; bf16x8 pa0, pa1, pa2, pa3; const int NT = seq / KVBLK;
  constexpr int SE = 0, SO = 1;
  SLOAD(SE, 0); asm volatile("s_waitcnt vmcnt(0)" ::: "memory"); SWRITE(0, SE); __syncthreads();
  qkt(pA0, pA1, K_lds, qr, r32, hi); partialSM(pA0, pA1, m_reg, mnA, alA);
  SLOAD(SO, KVBLK); if (2 < NT) SLOAD(SE, 2 * KVBLK);
  SWAIT(); SWRITE(1, SO); __syncthreads();
  for (int j = 1; j + 1 < NT; j += 2) {
    SBAR(); qkt(pB0, pB1, K_lds + SHM_K, qr, r32, hi);
    finishSM(pA0, pA1, alA, l_reg, pa0, pa1, pa2, pa3); SBAR();
    SLOAD(SO, (j + 2) * KVBLK); SBAR();
    pv_d0(o, vb0, pa0, pa1, pa2, pa3); partialSM(pB0, pB1, m_reg, mnB, alB);
    __syncthreads(); SWAIT(); SWRITE(0, SE);
    RESC(alB); __syncthreads();
    SBAR(); qkt(pA0, pA1, K_lds, qr, r32, hi);
    finishSM(pB0, pB1, alB, l_reg, pa0, pa1, pa2, pa3); SBAR();
    if (j + 3 < NT) SLOAD(SE, (j + 3) * KVBLK); SBAR();
    pv_d0(o, vb0 + SHM_V, pa0, pa1, pa2, pa3); partialSM(pA0, pA1, m_reg, mnA, alA);
    __syncthreads(); SWAIT(); SWRITE(1, SO);
    RESC(alA); __syncthreads();
  }
  SBAR(); qkt(pB0, pB1, K_lds + SHM_K, qr, r32, hi);
  finishSM(pA0, pA1, alA, l_reg, pa0, pa1, pa2, pa3); SBAR();
  pv_d0(o, vb0, pa0, pa1, pa2, pa3); partialSM(pB0, pB1, m_reg, mnB, alB);
  __syncthreads(); RESC(alB);
  finishSM(pB0, pB1, alB, l_reg, pa0, pa1, pa2, pa3); SBAR();
  pv_d0(o, vb0 + SHM_V, pa0, pa1, pa2, pa3);
  if (hi == 0) li_l[r32] = l_reg; asm volatile("s_waitcnt lgkmcnt(0)" ::: "memory");
  float rli[16];
#pragma unroll
  for (int r = 0; r < 16; ++r) rli[r] = __builtin_amdgcn_rcpf(li_l[crow(r, hi)]);
  bf16_t* Ow = Ob + (long)(wid * QBLK) * DM;
#pragma unroll
  for (int r = 0; r < 16; ++r) { const int orow = crow(r, hi);
#pragma unroll
    for (int d0 = 0; d0 < 2; ++d0) Ow[(long)orow * DM + d0 * 32 + r32] = (bf16_t)f2bf(o[d0][r] * rli[r]); }
  __syncthreads();
#undef SLOAD
#undef SWRITE
#undef SWAIT
#undef RESC
}
#undef KSWZ
#undef SBAR
}

__device__ __forceinline__ void phase_attn(const Params& P, bool with_ctx, int vcu, int G, unsigned char* lds) {
    const bf16_t* Q = (const bf16_t*)(P.ws + WS_Q); const bf16_t* KV = (const bf16_t*)(P.ws + WS_KV); const bf16_t* KR = (const bf16_t*)(P.ws + WS_KROPE); bf16_t* mix = (bf16_t*)(P.ws + WS_H);
    const int nu = NBATCH * NHEAD * 8 + (with_ctx ? NBATCH * NHEAD : 0);
    for (int uid = vcu; uid < nu; uid += G) {
        int b, h, row0, seq;
        if (uid < NBATCH * NHEAD * 8) { const int bh = uid >> 3, qb = uid & 7; b = bh >> 3; h = bh & 7; row0 = b * TPB + CTXL + qb * 256; seq = TPB; }
        else { const int bh = uid - NBATCH * NHEAD * 8; b = bh >> 3; h = bh & 7; row0 = b * TPB; seq = CTXL; }
        attn::attn_unit(Q + (size_t)row0 * QW + h * DQK, KV + (size_t)(b * TPB) * KVW + h * 128, KR + (size_t)(b * TPB) * DROPE, mix + (size_t)row0 * DM + h * DV, seq, (char*)lds);
    }
}

#define LAS __attribute__((address_space(3)))
__device__ __forceinline__ void phase_gemm_in(const Params& P, int l, LAS unsigned char* lds) {
    pg8::Gemm g{(const bf16_t*)(P.ws + WS_H), wptr(P, l, WO_WIN), NR, INP, DM, DM}; pg8::StaticOrder S; S.init(NR, INP, gridDim.x, blockIdx.x);
    EpiBf16S E{(bf16_t*)(P.ws + WS_PROJ), INP, nullptr};
    pg8::gemm_phase<EpiBf16S, pg8::StaticOrder, true, true>(lds, g, S, E);
}
__device__ __forceinline__ void phase_gemm_q(const Params& P, int l, LAS unsigned char* lds) {
    pg8::Gemm g{(const bf16_t*)(P.ws + WS_PROJ) + C_QA, wptr(P, l, WO_WQB), NR, QW, 256, INP}; pg8::StaticOrder S; S.init(NR, QW, gridDim.x, blockIdx.x);
    EpiBf16S E{(bf16_t*)(P.ws + WS_Q), QW, (const float*)(P.ws + WS_RQA)};
    pg8::gemm_phase<EpiBf16S, pg8::StaticOrder, true, true>(lds, g, S, E);
}
__device__ __forceinline__ void phase_gemm_kv(const Params& P, int l, LAS unsigned char* lds) {
    pg8::Gemm g{(const bf16_t*)(P.ws + WS_PROJ) + C_KVA, wptr(P, l, WO_WKVB), NR, KVW, 256, INP}; pg8::StaticOrder S; S.init(NR, KVW, gridDim.x, blockIdx.x);
    EpiBf16S E{(bf16_t*)(P.ws + WS_KV), KVW, (const float*)(P.ws + WS_RKVA)};
    pg8::gemm_phase<EpiBf16S, pg8::StaticOrder, true, true>(lds, g, S, E);
}
__device__ __forceinline__ void phase_gemm_out(const Params& P, int l, LAS unsigned char* lds) {
    pg8::Gemm g{(const bf16_t*)(P.ws + WS_H), wptr(P, l, WO_WOUT), NR, DM, DM, DM}; pg8::StaticOrder S; S.init(NR, DM, gridDim.x, blockIdx.x);
    EpiRes E{P.out, P.ws, l, 2};
    pg8::gemm_phase<EpiRes, pg8::StaticOrder, true, true>(lds, g, S, E);
}
__device__ __forceinline__ void phase_gemm_ffi(const Params& P, int l, LAS unsigned char* lds) {
    pg8::Gemm g{(const bf16_t*)(P.ws + WS_H), wptr(P, l, WO_WFI), NR, 2 * DFF, DM, DM}; pg8::StaticOrder S; S.init(NR, 2 * DFF, gridDim.x, blockIdx.x);
    EpiSwiglu E{(bf16_t*)(P.ws + WS_ACT), DFF};
    pg8::gemm_phase<EpiSwiglu, pg8::StaticOrder, true, true>(lds, g, S, E);
}
__device__ __forceinline__ void phase_gemm_ffo(const Params& P, int l, LAS unsigned char* lds) {
    pg8::Gemm g{(const bf16_t*)(P.ws + WS_ACT), wptr(P, l, WO_WFO), NR, DM, DFF, DFF}; pg8::StaticOrder S; S.init(NR, DM, gridDim.x, blockIdx.x);
    EpiRes E{P.out, P.ws, l, 5};
    pg8::gemm_phase<EpiRes, pg8::StaticOrder, true, true>(lds, g, S, E);
}

#ifndef FAST_GEMM
#define FAST_GEMM 1
#endif
#ifndef FAST_ATTN
#define FAST_ATTN 1
#endif
enum { ST_WPREP = 0, ST_MOD, ST_NORM, ST_GEMM_IN, ST_ROWSTAT, ST_GEMM_Q, ST_GEMM_KV, ST_QROPE, ST_LRU, ST_SGU, ST_ATTN, ST_FINAL, ST_GEMM_OUT, ST_GEMM_FFI, ST_GEMM_FFO };
template <int stage> __global__ void __launch_bounds__(NTHR, 2) k_stage(Params P, int l, int mode) {
    extern __shared__ __attribute__((aligned(16))) unsigned char lds[];
    const int bid = blockIdx.x, nb = gridDim.x;
    LAS unsigned char* lds3 = (LAS unsigned char*)lds;
    bf16_t* H = (bf16_t*)(P.ws + WS_H); bf16_t* PROJ = (bf16_t*)(P.ws + WS_PROJ);
    switch (stage) {
    case ST_WPREP: stage_wprep(P, bid, nb, lds); break;
    case ST_MOD: stage_mod(P, bid, nb, lds); break;
    case ST_NORM: stage_norm(P, l, mode, bid, nb); break;
    case ST_ROWSTAT: stage_rowstat(P, bid, nb); break;
    case ST_QROPE: stage_qrope(P, bid, nb); break;
    case ST_LRU: stage_lru_local(P, l, bid, nb, lds); break;
    case ST_SGU: stage_sgu(P, l, bid, nb, lds); break;
    case ST_FINAL: stage_finalize(P, bid, nb, lds); break;
#if FAST_ATTN
    case ST_ATTN: { const int G = gridDim.x, bx = blockIdx.x; const int vcu = (G % 8 == 0) ? (bx % 8) * (G / 8) + bx / 8 : bx; phase_attn(P, mode != 0, vcu, G, lds); } break;
#else
    case ST_ATTN: stage_refattn(P, bid, nb, lds); break;
#endif
#if FAST_GEMM
    case ST_GEMM_IN: phase_gemm_in(P, l, lds3); break;
    case ST_GEMM_Q: phase_gemm_q(P, l, lds3); break;
    case ST_GEMM_KV: phase_gemm_kv(P, l, lds3); break;
    case ST_GEMM_OUT: phase_gemm_out(P, l, lds3); break;
    case ST_GEMM_FFI: phase_gemm_ffi(P, l, lds3); break;
    case ST_GEMM_FFO: phase_gemm_ffo(P, l, lds3); break;
#else
    case ST_GEMM_IN: { RefGemm g{H, DM, wptr(P, l, WO_WIN), NR, INP, DM, 0, PROJ, INP, nullptr, l, 0}; stage_refgemm(P, g, bid, nb, lds); } break;
    case ST_GEMM_Q: { RefGemm g{PROJ + C_QA, INP, wptr(P, l, WO_WQB), NR, QW, 256, 0, (bf16_t*)(P.ws + WS_Q), QW, (const float*)(P.ws + WS_RQA), l, 0}; stage_refgemm(P, g, bid, nb, lds); } break;
    case ST_GEMM_KV: { RefGemm g{PROJ + C_KVA, INP, wptr(P, l, WO_WKVB), NR, KVW, 256, 0, (bf16_t*)(P.ws + WS_KV), KVW, (const float*)(P.ws + WS_RKVA), l, 0}; stage_refgemm(P, g, bid, nb, lds); } break;
    case ST_GEMM_OUT: { RefGemm g{H, DM, wptr(P, l, WO_WOUT), NR, DM, DM, 1, nullptr, 0, nullptr, l, 2}; stage_refgemm(P, g, bid, nb, lds); } break;
    case ST_GEMM_FFI: { RefGemm g{H, DM, wptr(P, l, WO_WFI), NR, 2 * DFF, DM, 2, (bf16_t*)(P.ws + WS_ACT), DFF, nullptr, l, 0}; stage_refgemm(P, g, bid, nb, lds); } break;
    case ST_GEMM_FFO: { RefGemm g{(bf16_t*)(P.ws + WS_ACT), DFF, wptr(P, l, WO_WFO), NR, DM, DFF, 1, nullptr, 0, nullptr, l, 5}; stage_refgemm(P, g, bid, nb, lds); } break;
#endif
    }
}

extern "C" void kernel_launch(void* const* d_in, const int* in_sizes, int n_in, void* d_out, int out_size, void* d_ws, size_t ws_size, hipStream_t stream) {
    static int ok = 0;
    if (ok == 0) {
        if (n_in != 28 || out_size != NBATCH * SEQ * DM || ws_size < WS_END) { fprintf(stderr, "kernel_launch: unexpected shapes n_in %d out %d ws %zu\n", n_in, out_size, ws_size); ok = -1; return; }
#define SETA(st) if (hipFuncSetAttribute((const void*)k_stage<st>, hipFuncAttributeMaxDynamicSharedMemorySize, LDS_BYTES) != hipSuccess) { fprintf(stderr, "hipFuncSetAttribute failed\n"); ok = -1; return; }
        SETA(ST_WPREP) SETA(ST_MOD) SETA(ST_NORM) SETA(ST_GEMM_IN) SETA(ST_ROWSTAT) SETA(ST_GEMM_Q) SETA(ST_GEMM_KV) SETA(ST_QROPE) SETA(ST_LRU) SETA(ST_SGU) SETA(ST_ATTN) SETA(ST_FINAL) SETA(ST_GEMM_OUT) SETA(ST_GEMM_FFI) SETA(ST_GEMM_FFO)
#undef SETA
        ok = 1;
    }
    if (ok < 0) return;
    Params P{};
    for (int i = 0; i < 28; ++i) P.in[i] = (const float*)d_in[i];
    P.out = (float*)d_out; P.ws = (unsigned char*)d_ws;
    (void)hipMemsetAsync((char*)d_ws + WS_CTL, 0, CTL_BYTES, stream);
    const int G = 256;
#define RUN(st, l, mode) hipLaunchKernelGGL(k_stage<st>, dim3(G), dim3(NTHR), LDS_BYTES, stream, P, (int)(l), (int)(mode))
    RUN(ST_WPREP, 0, 0); RUN(ST_MOD, 0, 0);
    RUN(ST_NORM, 0, 0);
    for (int l = 0; l < DEPTH; ++l) {
        RUN(ST_GEMM_IN, l, 0); RUN(ST_ROWSTAT, l, 0);
        RUN(ST_GEMM_Q, l, 0); RUN(ST_GEMM_KV, l, 0); RUN(ST_QROPE, l, 0);
        RUN(ST_LRU, l, 0); RUN(ST_SGU, l, 0); RUN(ST_ATTN, l, 1);
        RUN(ST_FINAL, l, 0);
        RUN(ST_GEMM_OUT, l, 0);
        RUN(ST_NORM, l, 1);
        RUN(ST_GEMM_FFI, l, 0); RUN(ST_GEMM_FFO, l, 0);
        if (l + 1 < DEPTH) RUN(ST_NORM, l + 1, 2); else RUN(ST_NORM, 0, 3);
    }
#undef RUN
}
```

```cpp
#include <hip/hip_runtime.h>
#include <stdint.h>
#include <stdio.h>

constexpr int DM = 1024, NBATCH = 16, SEQ = 2048, CTXL = 256, TPB = SEQ + CTXL  , NR = NBATCH * TPB  ;
constexpr int DEPTH = 2, GRIDW = 64;
constexpr int NHEAD = 8, DNOPE = 64, DROPE = 32, DQK = 96, DV = 64, QLORA = 256, KVLORA = 128;
constexpr int LRUW = 256, SGUW = 256, CHUNK = 128;
constexpr int INW = 1440, INP = 1536;
constexpr int C_QA = 0, C_KVA = 256, C_KR = 384, C_XR = 416, C_GR = 672, C_SU = 928, C_SV = 1184;
constexpr int DFF = 2816;
constexpr int QW = NHEAD * DQK  , KVW = NHEAD * (DNOPE + DV)  ;
constexpr float EPS = 1e-6f;
constexpr int NTHR = 512;
constexpr int LDS_BYTES = 147456;

constexpr size_t MiB = 1u << 20;
constexpr size_t WS_CTL = 0, CTL_BYTES = 2 * MiB;
constexpr size_t WS_MOD = 128 * 1024;
constexpr size_t WS_SMALL = 2 * MiB;
constexpr size_t WS_ROPE = WS_SMALL;
constexpr size_t WS_RQA = WS_SMALL + 64 * 1024;
constexpr size_t WS_LRUC = WS_SMALL + 16 * 1024;
constexpr size_t WS_RKVA = WS_RQA + NR * 4;
constexpr size_t WS_GS = WS_RKVA + NR * 4;
constexpr size_t WS_SHW = 3 * MiB;
static_assert(WS_GS + 2 * 2 * 17 * 1024 * 4 <= WS_SHW && WS_SHW + 2 * 17 * 7168 * 4 <= 4 * MiB, "small region");
constexpr size_t WS_ROWSS = 1 * MiB;
constexpr size_t WS_AGG = 449 * MiB;
constexpr size_t WS_W = 4 * MiB;
constexpr size_t WSZ_WIN = (size_t)INP * DM * 2, WSZ_WQB = (size_t)QW * 256 * 2, WSZ_WKVB = (size_t)KVW * 256 * 2, WSZ_WOUT = (size_t)DM * DM * 2,
                 WSZ_WFI = (size_t)2 * DFF * DM * 2, WSZ_WFO = (size_t)DM * DFF * 2;
constexpr size_t WO_WIN = 0, WO_WQB = WO_WIN + WSZ_WIN, WO_WKVB = WO_WQB + WSZ_WQB, WO_WOUT = WO_WKVB + WSZ_WKVB, WO_WFI = WO_WOUT + WSZ_WOUT, WO_WFO = WO_WFI + WSZ_WFI,
                 WSZ_LAYER = WO_WFO + WSZ_WFO;
static_assert(WS_W + 2 * WSZ_LAYER <= 49 * MiB, "weights");
constexpr size_t WS_WLRU = 49 * MiB;
constexpr size_t WS_WSGU = 50 * MiB;
constexpr size_t WS_CRES = 52 * MiB;
constexpr size_t WS_H = 68 * MiB;
constexpr size_t WS_PROJ = 140 * MiB;
constexpr size_t WS_Q = 248 * MiB;
constexpr size_t WS_KV = 302 * MiB;
constexpr size_t WS_KROPE = 374 * MiB;
constexpr size_t WS_H2 = 377 * MiB;
constexpr size_t WS_ACT = 140 * MiB;
constexpr size_t WS_ACTC = 452 * MiB;
constexpr size_t WS_END = 475 * MiB;
static_assert(WS_ACT + (size_t)NR * DFF * 2 <= WS_KROPE, "act overlay");
static_assert(WS_H2 + (size_t)NR * DM * 2 <= WS_AGG && WS_ROWSS + 4 * NR * 4 <= CTL_BYTES && WS_AGG + 3 * MiB <= WS_ACTC && WS_ACTC + (size_t)NBATCH * CTXL * DFF * 2 <= WS_END, "map");

typedef unsigned short bf16_t;
typedef float f32x4 __attribute__((ext_vector_type(4)));
typedef unsigned u32x4 __attribute__((ext_vector_type(4)));
typedef unsigned u32x2 __attribute__((ext_vector_type(2)));
typedef short bf16x8_t __attribute__((ext_vector_type(8)));

struct KArgs {
    const float* in[28];
    float* out;
    unsigned char* ws;
};
#define GAS1 __attribute__((address_space(1)))
struct Params {
    unsigned intab;
    GAS1 float* out;
    GAS1 unsigned char* ws;
    __device__ __forceinline__ const float* inp(int i) const {
        const unsigned long long v = *(const __attribute__((address_space(3))) unsigned long long*)(intab + 8u * (unsigned)i);
        const unsigned lo = __builtin_amdgcn_readfirstlane((unsigned)v), hi = __builtin_amdgcn_readfirstlane((unsigned)(v >> 32));
        return (const float*)(const __attribute__((address_space(1))) float*)(((unsigned long long)hi << 32) | lo);
    }
};

__device__ __forceinline__ int opaque_tid() { int t = threadIdx.x; asm volatile("" : "+v"(t)); return t; }
#define TIDX opaque_tid()
#define LOADS_ISSUED() asm volatile("" ::: "memory")
__device__ __forceinline__ unsigned f2bf(float f) { unsigned u = __builtin_bit_cast(unsigned, f); return (u + 0x7fffu + ((u >> 16) & 1u)) >> 16; }
__device__ __forceinline__ float bf2f(unsigned h) { return __builtin_bit_cast(float, (h & 0xffffu) << 16); }
__device__ __forceinline__ unsigned pk2(float lo, float hi) { return f2bf(lo) | (f2bf(hi) << 16); }
__device__ __forceinline__ float bflo(unsigned w) { return __builtin_bit_cast(float, w << 16); }
__device__ __forceinline__ float bfhi(unsigned w) { return __builtin_bit_cast(float, w & 0xffff0000u); }
#define DPP_ADD(v, ctrl) ((v) + __builtin_bit_cast(float, __builtin_amdgcn_update_dpp(0, __builtin_bit_cast(int, (v)), (ctrl), 0xF, 0xF, true)))
__device__ __forceinline__ float wave_sum(float v) {
    v = DPP_ADD(v, 0xB1); v = DPP_ADD(v, 0x4E); v = DPP_ADD(v, 0x141); v = DPP_ADD(v, 0x140);
    const int iv = __builtin_bit_cast(int, v);
    const float r0 = __builtin_bit_cast(float, __builtin_amdgcn_readlane(iv, 0)), r1 = __builtin_bit_cast(float, __builtin_amdgcn_readlane(iv, 16)),
                r2 = __builtin_bit_cast(float, __builtin_amdgcn_readlane(iv, 32)), r3 = __builtin_bit_cast(float, __builtin_amdgcn_readlane(iv, 48));
    return (r0 + r1) + (r2 + r3);
}
__device__ __forceinline__ float fexp_(float x) { return __builtin_amdgcn_exp2f(1.4426950408889634f * x); }
__device__ __forceinline__ float sigmoidf_(float x) { return __builtin_amdgcn_rcpf(1.f + __builtin_amdgcn_exp2f(-1.4426950408889634f * x)); }
__device__ __forceinline__ float siluf_(float x) { return x * __builtin_amdgcn_rcpf(1.f + __builtin_amdgcn_exp2f(-1.4426950408889634f * x)); }
__device__ __forceinline__ float geluf_(float x) {
    const float u2 = 1.5957691216057308f * (x + 0.044715f * x * x * x);
    return x * __builtin_amdgcn_rcpf(1.f + __builtin_amdgcn_exp2f(-1.4426950408889634f * u2));
}
__device__ __forceinline__ float* res_row(const Params& P, int r) {
    const int b = r / TPB, t = r - b * TPB;
    return t < CTXL ? (float*)(P.ws + WS_CRES) + ((size_t)(b * CTXL + t)) * DM : (float*)(P.out + ((size_t)(b * SEQ + (t - CTXL))) * DM);
}
__device__ __forceinline__ const float* modp(const Params& P, int l, int r, int chunk) {
    const int b = r / TPB, t = r - b * TPB; const int mr = t < CTXL ? 16 : b;
    return (const float*)(P.ws + WS_MOD) + ((size_t)(l * 17 + mr)) * 6144 + chunk * 1024;
}
__device__ __forceinline__ bf16_t* wptr(const Params& P, int l, size_t off) { return (bf16_t*)(P.ws + WS_W + (size_t)l * WSZ_LAYER + off); }

struct WItem { const float* W; int K, N; bf16_t* Wt; int KP, kind; const float* gain; int kt, nt4, nsub; };
__device__ __forceinline__ WItem wprep_decode(const Params& P, int it) {
    constexpr int I0 = 16 * 6, I1 = 4 * 3, I2 = 4 * 4, I3 = 16 * 4, I4 = 16 * 22, I5 = 44 * 4, IL = I0 + I1 + I2 + I3 + I4 + I5;
    if (it >= 2 * IL) {
        const int q = it - 2 * IL; const int l = q >> 4, d = (q >> 3) & 1, gate = (q >> 2) & 1, hh = q & 3;
        return WItem{(gate ? P.inp(17) : P.inp(15)) + ((size_t)((l * 2 + d) * 4 + hh)) * 4096, 64, 64, (bf16_t*)(P.ws + WS_WLRU) + ((size_t)(((l * 2 + d) * 2 + gate) * 4 + hh)) * 4096, 64, 6, nullptr, 0, 0, 1}; }
    const int l = it / IL; int r = it % IL;
    if (r < I0) return WItem{P.inp(8) + (size_t)l * DM * INW, DM, INW, wptr(P, l, WO_WIN), DM, 0, nullptr, r % 16, r / 16, 4}; r -= I0;
    if (r < I1) return WItem{P.inp(10) + (size_t)l * QLORA * QW, QLORA, QW, wptr(P, l, WO_WQB), 256, 1, P.inp(9) + l * QLORA, r % 4, r / 4, 4}; r -= I1;
    if (r < I2) return WItem{P.inp(12) + (size_t)l * KVLORA * KVW, KVLORA, KVW, wptr(P, l, WO_WKVB), 256, 2, P.inp(11) + l * KVLORA, r % 4, r / 4, 4}; r -= I2;
    if (r < I3) return WItem{P.inp(24) + (size_t)l * DM * DM, DM, DM, wptr(P, l, WO_WOUT), DM, 3, P.inp(23) + l * DM, r % 16, r / 16, 4}; r -= I3;
    if (r < I4) return WItem{P.inp(25) + (size_t)l * DM * 2 * DFF, DM, 2 * DFF, wptr(P, l, WO_WFI), DM, 4, nullptr, r % 16, r / 16, 4}; r -= I4;
    return WItem{P.inp(26) + (size_t)l * DFF * DM, DFF, DM, wptr(P, l, WO_WFO), DFF, 5, nullptr, r % 44, r / 44, 4};
}
__device__ __forceinline__ int wprep_src(const WItem& w, int e, int& k, int& sub, int& n4, bool& ok) {
    sub = e / 1024; const int r = e % 1024; k = r >> 4; n4 = r & 15; const int nn = w.nt4 * 256 + sub * 64, k0 = w.kt * 64;
    int s0; if (w.kind == 4) { const int pn = nn / 256, half = (nn % 256) / 128, jj = nn % 128; s0 = half * DFF + pn * 128 + jj; } else s0 = nn;
    ok = (k0 + k < w.K) && (s0 + n4 * 4 < w.N);
    const int kk = (k0 + k < w.K) ? k0 + k : w.K - 1, cc = (s0 + n4 * 4 < w.N) ? s0 + n4 * 4 : 0;
    return kk * w.N + cc;
}
__device__ __forceinline__ void wprep_load(const WItem& w, int tid, f32x4 (&lv)[8]) {
#pragma unroll
    for (int q = 0; q < 8; ++q) { const int e = tid + q * NTHR; lv[q] = (f32x4){0.f, 0.f, 0.f, 0.f};
        if (e < 64 * 16 * w.nsub) { int k, sub, n4; bool ok; const int off = wprep_src(w, e, k, sub, n4, ok); lv[q] = *(const f32x4*)(w.W + off); } }
}
__device__ __forceinline__ void wprep_store(const WItem& w, int tid, const f32x4 (&lv)[8], float* t  ) {
    __syncthreads();
#pragma unroll
    for (int q = 0; q < 8; ++q) { const int e = tid + q * NTHR;
        if (e < 64 * 16 * w.nsub) { int k, sub, n4; bool ok; (void)wprep_src(w, e, k, sub, n4, ok); f32x4 v = lv[q];
            if (w.gain) v = v * w.gain[(w.kt * 64 + k < w.K) ? w.kt * 64 + k : w.K - 1];
            if (!ok) v = (f32x4){0.f, 0.f, 0.f, 0.f};
            float* tp = t + k * 260 + sub * 65 + n4 * 4; tp[0] = v.x; tp[1] = v.y; tp[2] = v.z; tp[3] = v.w; } }
    __syncthreads();
    for (int e = tid; e < 64 * 8 * w.nsub; e += NTHR) { const int n = e >> 3, k8 = e & 7, sub = n >> 6, nl = n & 63; const float* tp = t + (k8 * 8) * 260 + sub * 65 + nl;
        u32x4 o; o.x = pk2(tp[0], tp[260]); o.y = pk2(tp[2 * 260], tp[3 * 260]); o.z = pk2(tp[4 * 260], tp[5 * 260]); o.w = pk2(tp[6 * 260], tp[7 * 260]);
        *(u32x4*)(w.Wt + (size_t)(w.nt4 * 256 + n) * w.KP + w.kt * 64 + k8 * 8) = o; }
}
__device__ __forceinline__ void stage_wprep(const Params& P, int bid, int nb, unsigned char* lds) {
    float* t = (float*)lds; const int tid = TIDX;
    constexpr int NIT = 2 * (16 * 6 + 4 * 3 + 4 * 4 + 16 * 4 + 16 * 22 + 44 * 4) + 32;
    f32x4 la[8], lb[8];
    int it = bid;
    if (it < NIT) { const WItem w = wprep_decode(P, it); wprep_load(w, tid, la); }
#pragma unroll 1
    for (; it < NIT; it += 2 * nb) {
        const WItem wa = wprep_decode(P, it);
        const bool hasb = it + nb < NIT;
        if (hasb) { const WItem wb = wprep_decode(P, it + nb); wprep_load(wb, tid, lb); }
        LOADS_ISSUED();
        wprep_store(wa, tid, la, t);
        if (!hasb) break;
        if (it + 2 * nb < NIT) { const WItem wn = wprep_decode(P, it + 2 * nb); wprep_load(wn, tid, la); }
        LOADS_ISSUED();
        { const WItem wb = wprep_decode(P, it + nb); wprep_store(wb, tid, lb, t); }
    }
    { bf16_t* Wd = (bf16_t*)(P.ws + WS_WSGU); const float* Wsrc = P.inp(21);
      for (int e = (bid * NTHR + tid) * 4; e < 2 * 4 * 16384; e += nb * NTHR * 4) { const f32x4 v = *(const f32x4*)(Wsrc + e); u32x2 w; w.x = pk2(v.x, v.y); w.y = pk2(v.z, v.w); *(u32x2*)(Wd + e) = w; } }
}

__device__ __forceinline__ void stage_mod(const Params& P, int bid, int nb, unsigned char* lds, size_t dst_off = WS_MOD) {
    const int tid = TIDX;
    if (bid == 0) {
        float* tab = (float*)(P.ws + WS_ROPE); const int p = tid >> 3, j = tid & 7;
        const float f = powf(10000.0f, -(float)j / 8.0f); const float a = (float)p * f;
        tab[tid] = cosf(a); tab[512 + tid] = sinf(a);
    }
    float* s = (float*)lds;
    float* red = s + 17 * 128;
    float* mod = (float*)(P.ws + dst_off);
    for (int it = bid; it < 2 * 96 * 8; it += nb) {
        const int l = it / 768, r = it % 768, cg = r / 8, kc = r % 8, n0 = cg * 64, k0 = kc * 128;
        __syncthreads();
        const int col = tid & 63, ks = tid >> 6;
        const float* w = P.inp(6) + ((size_t)l * DM + k0 + ks * 16) * 6144 + n0 + col;
        float wv[16], cv5[5];
        { const float* cp = P.inp(1); const float* cx = P.inp(3);
#pragma unroll
          for (int q = 0; q < 5; ++q) { const int e = tid + q * NTHR; const int ee = e < 17 * 128 ? e : 0; const int i = ee >> 7, k = ee & 127; const float* src = i < 16 ? cp + i * DM + k0 + k : cx + k0 + k; cv5[q] = *src; }
#pragma unroll
          for (int kk = 0; kk < 16; ++kk) wv[kk] = w[(size_t)kk * 6144]; }
        LOADS_ISSUED();
#pragma unroll
        for (int q = 0; q < 5; ++q) { const int e = tid + q * NTHR; if (e < 17 * 128) s[e] = siluf_(cv5[q]); }
        __syncthreads();
        float acc[17];
#pragma unroll
        for (int i = 0; i < 17; ++i) acc[i] = 0.f;
#pragma unroll
        for (int kk = 0; kk < 16; ++kk) {
#pragma unroll
            for (int i = 0; i < 17; ++i) acc[i] += s[i * 128 + ks * 16 + kk] * wv[kk]; }
#pragma unroll
        for (int i = 0; i < 17; ++i) red[(ks * 17 + i) * 64 + col] = acc[i];
        __syncthreads();
        for (int e = tid; e < 17 * 64; e += NTHR) { const int i = e >> 6, c = e & 63; float v = 0.f;
#pragma unroll
            for (int q = 0; q < 8; ++q) v += red[(q * 17 + i) * 64 + c];
            if (kc == 0) v += P.inp(7)[l * 6144 + n0 + c];
            atomicAdd(mod + ((size_t)(l * 17 + i)) * 6144 + n0 + c, v); }
    }
}

__device__ __forceinline__ void stage_tables(const Params& P, int bid, int nb, unsigned char* lds) {
    const int tid = TIDX, lane = tid & 63, w = tid >> 6, fr = lane & 15, fq = lane >> 4;
    const float* mod = (const float*)(P.ws + WS_MOD);
    constexpr int SH_P = 1032;
    bf16_t* sh = (bf16_t*)lds;
    for (int it = bid; it < 112; it += nb) {
        const int l = it / 56, ch = it % 56, which = ch < 12 ? 0 : 1; const int n0 = ch * 128 + w * 16;
        __syncthreads();
        for (int e = tid; e < 32 * 1024; e += NTHR) { const int i = e >> 10, k = e & 1023; sh[i * SH_P + k] = i < 17 ? (bf16_t)f2bf(mod[((size_t)(l * 17 + i)) * 6144 + (which ? 3 : 0) * 1024 + k]) : (bf16_t)0; }
        __syncthreads();
        const bf16_t* wrow = (which ? wptr(P, l, WO_WFI) + (size_t)(n0 - 1536 + fr) * DM : wptr(P, l, WO_WIN) + (size_t)(n0 + fr) * DM) + fq * 8;
        f32x4 a0 = (f32x4){0.f, 0.f, 0.f, 0.f}, a1 = (f32x4){0.f, 0.f, 0.f, 0.f};
#pragma unroll 4
        for (int ks = 0; ks < 32; ++ks) { const bf16x8_t B = *(const bf16x8_t*)(wrow + ks * 32);
            const bf16x8_t A0 = *(const bf16x8_t*)(sh + fr * SH_P + ks * 32 + fq * 8), A1 = *(const bf16x8_t*)(sh + (16 + fr) * SH_P + ks * 32 + fq * 8);
            a0 = __builtin_amdgcn_mfma_f32_16x16x32_bf16(A0, B, a0, 0, 0, 0); a1 = __builtin_amdgcn_mfma_f32_16x16x32_bf16(A1, B, a1, 0, 0, 0); }
        float* shw = (float*)(P.ws + WS_SHW) + (size_t)(l * 17) * 7168 + n0 + fr;
#pragma unroll
        for (int reg = 0; reg < 4; ++reg) shw[(size_t)(fq * 4 + reg) * 7168] = a0[reg];
        if (fq == 0) shw[(size_t)16 * 7168] = a1[0];
    }
    if (bid == nb - 1) { f32x4* lc = (f32x4*)(P.ws + WS_LRUC);
        for (int e = tid; e < 2 * 2 * 256; e += NTHR) { const float lam = P.inp(19)[e]; lc[e] = (f32x4){P.inp(16)[e], P.inp(18)[e], -8.f * ((lam > 15.f) ? __expf(-lam) : log1pf(__expf(-lam))), 0.f}; } }
    float* gs = (float*)(P.ws + WS_GS);
    for (int e = bid * NTHR + tid; e < 2 * 2 * 17 * 1024; e += nb * NTHR) { const int k = e & 1023, i = (e >> 10) % 17, wq = ((e >> 10) / 17) & 1, l = (e >> 10) / 34;
        gs[e] = (wq ? P.inp(5) : P.inp(4))[l * DM + k] * (1.f + mod[((size_t)(l * 17 + i)) * 6144 + (wq ? 4 : 1) * 1024 + k]); }
}
__device__ __forceinline__ void stage_entry(const Params& P, int bid, int nb) {
    const int lane = TIDX & 63, gw = bid * (NTHR / 64) + (TIDX >> 6), ngw = nb * (NTHR / 64);
    bf16_t* H = (bf16_t*)(P.ws + WS_H); float* rowss = (float*)(P.ws + WS_ROWSS);
    for (int r = gw; r < NR; r += ngw) {
        const int b = r / TPB, t = r - b * TPB; const bool isctx = t < CTXL;
        const float* src = isctx ? P.inp(2) + ((size_t)(b * CTXL + t)) * DM : P.inp(0) + ((size_t)(b * SEQ + t - CTXL)) * DM;
        f32x4 v[4], gv[4], scv[4]; float ss = 0.f;
        const float* g = P.inp(4); const float* sc = modp(P, 0, r, 1);
#pragma unroll
        for (int j = 0; j < 4; ++j) { const int c = j * 256 + lane * 4; v[j] = *(const f32x4*)(src + c); gv[j] = *(const f32x4*)(g + c); scv[j] = *(const f32x4*)(sc + c); }
        LOADS_ISSUED();
#pragma unroll
        for (int j = 0; j < 4; ++j) ss += v[j].x * v[j].x + v[j].y * v[j].y + v[j].z * v[j].z + v[j].w * v[j].w;
        ss = wave_sum(ss);
        if (lane == 0) rowss[r] = ss;
#pragma unroll
        for (int j = 0; j < 4; ++j) { const int c = j * 256 + lane * 4;
            const f32x4 y = v[j] * gv[j] * (1.f + scv[j]);
            u32x2 w; w.x = pk2(y.x, y.y); w.y = pk2(y.z, y.w);
            *(u32x2*)(H + (size_t)r * DM + c) = w; }
    }
}

__device__ __forceinline__ void stage_norm(const Params& P, int l, int mode, int bid, int nb, int skipctx = 0) {
    const int lane = TIDX & 63, gw = bid * (NTHR / 64) + (TIDX >> 6), ngw = nb * (NTHR / 64);
    bf16_t* H = (bf16_t*)(P.ws + WS_H);
    for (int r = gw; r < NR; r += ngw) {
        const int b = r / TPB, t = r - b * TPB; const bool isctx = t < CTXL;
        if ((mode == 3 || skipctx) && isctx) continue;
        float* res = res_row(P, r);
        const float* src = res;
        if (mode == 0) src = isctx ? P.inp(2) + ((size_t)(b * CTXL + t)) * DM : P.inp(0) + ((size_t)(b * SEQ + t - CTXL)) * DM;
        f32x4 v[4]; float ss = 0.f;
#pragma unroll
        for (int j = 0; j < 4; ++j) { v[j] = *(const f32x4*)(src + j * 256 + lane * 4); ss += v[j].x * v[j].x + v[j].y * v[j].y + v[j].z * v[j].z + v[j].w * v[j].w; }
        ss = wave_sum(ss);
        const float rs = rsqrtf(ss * (1.f / DM) + EPS);
        if (mode == 0) {
#pragma unroll
            for (int j = 0; j < 4; ++j) *(f32x4*)(res + j * 256 + lane * 4) = v[j];
        }
        if (mode == 3) {
            const float* g = P.inp(27); f32x4 gv[4];
#pragma unroll
            for (int j = 0; j < 4; ++j) gv[j] = *(const f32x4*)(g + j * 256 + lane * 4);
            LOADS_ISSUED();
#pragma unroll
            for (int j = 0; j < 4; ++j) { f32x4 o = v[j] * rs * gv[j]; *(f32x4*)(res + j * 256 + lane * 4) = o; }
            continue;
        }
        const float* g = (mode == 1 ? P.inp(5) : P.inp(4)) + l * DM;
        const float* sh = modp(P, l, r, mode == 1 ? 3 : 0);
        const float* sc = modp(P, l, r, mode == 1 ? 4 : 1);
#pragma unroll
        for (int j = 0; j < 4; ++j) { const int c = j * 256 + lane * 4;
            const f32x4 gv = *(const f32x4*)(g + c), shv = *(const f32x4*)(sh + c), scv = *(const f32x4*)(sc + c);
            const f32x4 y = (v[j] * rs * gv) * (1.f + scv) + shv;
            u32x2 w; w.x = pk2(y.x, y.y); w.y = pk2(y.z, y.w);
            *(u32x2*)(H + (size_t)r * DM + c) = w; }
    }
}

__device__ __forceinline__ float rope_one(const float* tab, float x, float partner, int i, int prow, int pcol) {
    const int p = (i < 16) ? prow : pcol; const float c = tab[p * 8 + (i & 7)], s = tab[512 + p * 8 + (i & 7)];
    const float rot = (i & 8) ? partner : -partner;
    return x * c + rot * s;
}
__device__ __forceinline__ void rowstat_item(const Params& P, int item) {
    const int lane = TIDX & 63, w = TIDX >> 6;
    bf16_t* proj = (bf16_t*)(P.ws + WS_PROJ); const float* tab = (const float*)(P.ws + WS_ROPE); bf16_t* krope = (bf16_t*)(P.ws + WS_KROPE);
    { const int rb = item * 128 + w * 16;
        u32x2 a[16]; unsigned k[16]; unsigned short xr[16];
#pragma unroll
        for (int i = 0; i < 16; ++i) { const bf16_t* pr = proj + (size_t)(rb + i) * INP; a[i] = *(const u32x2*)(pr + C_QA + lane * 4); k[i] = *(const unsigned*)(pr + C_KVA + lane * 2); xr[i] = pr[C_KR + (lane & 31)]; }
        float rc[16], rsn[16];
#pragma unroll
        for (int i = 0; i < 16; ++i) { const int r = rb + i; const int t = r % TPB; const int pos = t >= CTXL ? t - CTXL : 0; const int ii = lane & 31; const int p = (ii < 16) ? (pos / GRIDW) : (pos % GRIDW);
            rc[i] = tab[p * 8 + (ii & 7)]; rsn[i] = tab[512 + p * 8 + (ii & 7)]; }
        LOADS_ISSUED();
#pragma unroll
        for (int i = 0; i < 16; ++i) { const int r = rb + i; bf16_t* pr = proj + (size_t)r * INP;
            const float a0 = bflo(a[i].x), a1 = bfhi(a[i].x), a2 = bflo(a[i].y), a3 = bfhi(a[i].y), k0 = bflo(k[i]), k1 = bfhi(k[i]);
            const float s1 = wave_sum(a0 * a0 + a1 * a1 + a2 * a2 + a3 * a3), s2 = wave_sum(k0 * k0 + k1 * k1);
            const float r1 = rsqrtf(s1 * (1.f / QLORA) + EPS), r2 = rsqrtf(s2 * (1.f / KVLORA) + EPS);
            u32x2 ao; ao.x = pk2(a0 * r1, a1 * r1); ao.y = pk2(a2 * r1, a3 * r1);
            *(u32x2*)(pr + C_QA + lane * 4) = ao; *(unsigned*)(pr + C_KVA + lane * 2) = pk2(k0 * r2, k1 * r2);
            const int t = r % TPB;
            const float x = bf2f(xr[i]); const float partner = __shfl_xor(x, 8);
            float y = x;
            if (t >= CTXL) { const float rot = (lane & 8) ? partner : -partner; y = x * rc[i] + rot * rsn[i]; }
            if (lane < 32) krope[(size_t)r * DROPE + lane] = (bf16_t)f2bf(y); }
    }
}

constexpr int XCB_P = 264;
constexpr int HS_P = 264;
constexpr int LRU_XCB = 0, LRU_CARRY = 64 * XCB_P * 2  , LRU_HS = 36864;
template <int DIR, bool WANT_H> __device__ __forceinline__ void lru_scan4(const float (&a)[4], const float (&bq)[4], int lane, float& hm, float& ptile, float (&hout)[4]) {
    const int q = lane >> 4, qq = DIR ? 3 - q : q;
    float Pl[4], Hl[4]; float hh = 0.f, pp = 1.f;
#pragma unroll
    for (int ri = 0; ri < 4; ++ri) { const int reg = DIR ? 3 - ri : ri; hh = a[reg] * hh + bq[reg]; pp *= a[reg]; Pl[reg] = pp; Hl[reg] = hh; }
    float As = pp, Bs = hh;
    { const float A1 = DIR ? __shfl_down(As, 16) : __shfl_up(As, 16), B1 = DIR ? __shfl_down(Bs, 16) : __shfl_up(Bs, 16);
      if (qq >= 1) { Bs = As * B1 + Bs; As = A1 * As; } }
    { const float A2 = DIR ? __shfl_down(As, 32) : __shfl_up(As, 32), B2 = DIR ? __shfl_down(Bs, 32) : __shfl_up(Bs, 32);
      if (qq >= 2) { Bs = As * B2 + Bs; As = A2 * As; } }
    const int last_lane = (lane & 15) + (DIR ? 0 : 48);
    const float At = __shfl(As, last_lane), Bt = __shfl(Bs, last_lane);
    if (WANT_H) {
        float Ae = DIR ? __shfl_down(As, 16) : __shfl_up(As, 16), Be = DIR ? __shfl_down(Bs, 16) : __shfl_up(Bs, 16);
        if (qq == 0) { Ae = 1.f; Be = 0.f; }
        const float hin = Ae * hm + Be;
#pragma unroll
        for (int reg = 0; reg < 4; ++reg) hout[reg] = Hl[reg] + Pl[reg] * hin; }
    hm = At * hm + Bt; ptile *= At;
}
template <int PASS> __device__ __forceinline__ void lru_item(const Params& P, int l, int b, int j, unsigned char* lds) {
    const int tid = TIDX, lane = tid & 63, w = tid >> 6;
    bf16_t* xcb = (bf16_t*)(lds + LRU_XCB); float* carry = (float*)(lds + LRU_CARRY); bf16_t* hs = (bf16_t*)(lds + LRU_HS);
    const bf16_t* proj = (const bf16_t*)(P.ws + WS_PROJ); float* agg = (float*)(P.ws + WS_AGG); bf16_t* mix = (bf16_t*)(P.ws + WS_H);
    u32x4* cab = (u32x4*)(P.ws + WS_H2) + ((size_t)((b * 36 + j) * 8 + w)) * 16 * 64 + lane;
    const int h = w & 3, d = w >> 2, fr = lane & 15, fq = lane >> 4;
    const int t0 = j * 64;
    if (PASS == 1) {
        const bf16_t* Wl = (const bf16_t*)(P.ws + WS_WLRU) + (size_t)l * 2 * 2 * 4 * 4096;
        const float* cw = P.inp(13) + l * 4 * LRUW; const float* cb = P.inp(14) + l * LRUW;
        const int seq_lo = j < 4 ? 0 : CTXL, seq_hi = j < 4 ? CTXL : TPB;
        __syncthreads();
        {
            const int c = tid & 255, th = tid >> 8; const int ts = t0 + th * 32;
            const float w0 = cw[c], w1 = cw[LRUW + c], w2 = cw[2 * LRUW + c], w3 = cw[3 * LRUW + c], bb = cb[c];
            float xv[35]; unsigned short xraw[35];
#pragma unroll
            for (int i = 0; i < 35; ++i) { const int t = ts - 2 + i; const int tc = t < seq_lo ? seq_lo : (t >= seq_hi ? seq_hi - 1 : t);
                xraw[i] = proj[(size_t)(b * TPB + tc) * INP + C_XR + c]; }
            LOADS_ISSUED();
#pragma unroll
            for (int i = 0; i < 35; ++i) { const int t = ts - 2 + i; xv[i] = (t >= seq_lo && t < seq_hi) ? bf2f(xraw[i]) : 0.f; }
#pragma unroll
            for (int i = 0; i < 32; ++i) xcb[(th * 32 + i) * XCB_P + c] = (bf16_t)f2bf(w0 * xv[i] + w1 * xv[i + 1] + w2 * xv[i + 2] + w3 * xv[i + 3] + bb);
        }
        bf16x8_t BfA[4][2][2]; f32x4 lcA[4];
        { const f32x4* lc = (const f32x4*)(P.ws + WS_LRUC) + (l * 2 + d) * 256 + h * 64 + fr;
#pragma unroll
          for (int nt = 0; nt < 4; ++nt) { lcA[nt] = lc[nt * 16];
#pragma unroll
              for (int gate = 0; gate < 2; ++gate)
#pragma unroll
                  for (int ks = 0; ks < 2; ++ks) BfA[nt][gate][ks] = *(const bf16x8_t*)(Wl + ((size_t)(((d * 2 + gate) * 4 + h) * 64 + nt * 16 + fr)) * 64 + ks * 32 + fq * 8); } }
        __syncthreads();
#pragma unroll
        for (int nt = 0; nt < 4; ++nt) {
            const int c = h * 64 + nt * 16 + fr;
            const float br = lcA[nt].x, bi = lcA[nt].y, m8sp = lcA[nt].z;
            float hm = 0.f, ptile = 1.f;
#pragma unroll
            for (int mi = 0; mi < 4; ++mi) { const int mt = d ? 3 - mi : mi;
                f32x4 aR = (f32x4){0.f, 0.f, 0.f, 0.f}, aI = (f32x4){0.f, 0.f, 0.f, 0.f};
#pragma unroll
                for (int ks = 0; ks < 2; ++ks) { const bf16x8_t A = *(const bf16x8_t*)(xcb + (mt * 16 + fr) * XCB_P + h * 64 + ks * 32 + fq * 8);
                    aR = __builtin_amdgcn_mfma_f32_16x16x32_bf16(A, BfA[nt][0][ks], aR, 0, 0, 0);
                    aI = __builtin_amdgcn_mfma_f32_16x16x32_bf16(A, BfA[nt][1][ks], aI, 0, 0, 0); }
                float a[4], bq[4], la[4];
#pragma unroll
                for (int reg = 0; reg < 4; ++reg) { const float r = sigmoidf_(aR[reg] + br), ig = sigmoidf_(aI[reg] + bi); la[reg] = m8sp * r;
                    const float x2 = 2.f * la[reg]; const float em = -x2 * (1.f + x2 * (0.5f + x2 * (0.16666667f + x2 * (0.041666668f + x2 * (0.0083333338f + x2 * 0.0013888889f)))));
                    const float xcv = bf2f(xcb[(mt * 16 + fq * 4 + reg) * XCB_P + c]); bq[reg] = __builtin_amdgcn_sqrtf(fmaxf(em, 0.f)) * (ig * xcv); }
                u32x4 pkv; pkv.x = pk2(la[0], bq[0]); pkv.y = pk2(la[1], bq[1]); pkv.z = pk2(la[2], bq[2]); pkv.w = pk2(la[3], bq[3]);
                cab[(nt * 4 + mi) * 64] = pkv;
                const unsigned pw[4] = {pkv.x, pkv.y, pkv.z, pkv.w};
#pragma unroll
                for (int reg = 0; reg < 4; ++reg) { a[reg] = fexp_(bflo(pw[reg])); bq[reg] = bfhi(pw[reg]); }
                float hout[4];
                if (d == 0) lru_scan4<0, false>(a, bq, lane, hm, ptile, hout); else lru_scan4<1, false>(a, bq, lane, hm, ptile, hout);
            }
            if (fq == 0) { float* ag = agg + ((size_t)((b * 36 + j) * 2 + d)) * 512; ag[c] = ptile; ag[256 + c] = hm; }
        }
    } else {
        u32x4 cv[16];
#pragma unroll
        for (int i = 0; i < 16; ++i) cv[i] = cab[i * 64];
        __syncthreads();
        {
            const int c = tid & 255, dd = tid >> 8; float cvv = 0.f; const float* ab = agg + ((size_t)(b * 36) * 2 + dd) * 512 + c;
            float Ag[36], Bg[36];
#pragma unroll
            for (int k = 0; k < 36; ++k) { Ag[k] = ab[(size_t)k * 1024]; Bg[k] = ab[(size_t)k * 1024 + 256]; }
            LOADS_ISSUED();
            if (dd == 0) {
#pragma unroll
                for (int k = 0; k < 36; ++k) if (k < j) cvv = Ag[k] * cvv + Bg[k];
            } else {
#pragma unroll
                for (int k = 3; k >= 0; --k) if (j >= 4 || k > j) cvv = Ag[k] * cvv + Bg[k];
#pragma unroll
                for (int k = 35; k >= 4; --k) if (j >= 4 && k > j) cvv = Ag[k] * cvv + Bg[k];
            }
            carry[dd * 256 + c] = cvv;
        }
        __syncthreads();
#pragma unroll
        for (int nt = 0; nt < 4; ++nt) {
            const int c = h * 64 + nt * 16 + fr;
            float hm = carry[d * 256 + c], ptile = 1.f;
#pragma unroll
            for (int mi = 0; mi < 4; ++mi) { const int mt = d ? 3 - mi : mi;
                const u32x4 pkv = cv[nt * 4 + mi]; const unsigned pw[4] = {pkv.x, pkv.y, pkv.z, pkv.w};
                float a[4], bq[4], hout[4];
#pragma unroll
                for (int reg = 0; reg < 4; ++reg) { a[reg] = fexp_(bflo(pw[reg])); bq[reg] = bfhi(pw[reg]); }
                if (d == 0) lru_scan4<0, true>(a, bq, lane, hm, ptile, hout); else lru_scan4<1, true>(a, bq, lane, hm, ptile, hout);
#pragma unroll
                for (int reg = 0; reg < 4; ++reg) hs[(d * 64 + mt * 16 + fq * 4 + reg) * HS_P + c] = (bf16_t)f2bf(hout[reg]);
            }
        }
        __syncthreads();
        u32x2 gwv[8];
#pragma unroll
        for (int tt = 0; tt < 8; ++tt) gwv[tt] = *(const u32x2*)(proj + ((size_t)b * TPB + t0 + w * 8 + tt) * INP + C_GR + lane * 4);
#pragma unroll
        for (int tt = 0; tt < 8; ++tt) { const int t = w * 8 + tt; const size_t row = (size_t)b * TPB + t0 + t;
            const u32x2 h0 = *(const u32x2*)(hs + t * HS_P + lane * 4), h1 = *(const u32x2*)(hs + (64 + t) * HS_P + lane * 4);
            const f32x4 hv = (f32x4){bflo(h0.x) + bflo(h1.x), bfhi(h0.x) + bfhi(h1.x), bflo(h0.y) + bflo(h1.y), bfhi(h0.y) + bfhi(h1.y)};
            const u32x2 gw = gwv[tt];
            const float v0 = hv.x * geluf_(bflo(gw.x)), v1 = hv.y * geluf_(bfhi(gw.x)), v2 = hv.z * geluf_(bflo(gw.y)), v3 = hv.w * geluf_(bfhi(gw.y));
            const float ss = wave_sum(v0 * v0 + v1 * v1 + v2 * v2 + v3 * v3); const float rs = rsqrtf(ss * (1.f / LRUW) + EPS);
            u32x2 o; o.x = pk2(v0 * rs, v1 * rs); o.y = pk2(v2 * rs, v3 * rs);
            *(u32x2*)(mix + row * DM + 512 + lane * 4) = o; }
    }
}

constexpr int VGT_P = 136;
constexpr int SGT_P = 264;
__device__ __forceinline__ void sgu_item(const Params& P, int l, int b, int n, unsigned char* lds) {
    const int tid = TIDX, lane = tid & 63, w = tid >> 6, fr = lane & 15, fq = lane >> 4;
    bf16_t* vgT = (bf16_t*)lds; bf16_t* T = (bf16_t*)lds;
    const bf16_t* proj = (const bf16_t*)(P.ws + WS_PROJ); bf16_t* mix = (bf16_t*)(P.ws + WS_H);
    const int g = w & 3, ph = w >> 2;
    const bf16_t* Wg = (const bf16_t*)(P.ws + WS_WSGU) + (size_t)(l * 4 + g) * 16384;
    {
        const size_t row0 = (size_t)b * TPB + n * CHUNK;
        bf16x8_t Af[4][4];
#pragma unroll
        for (int mt = 0; mt < 4; ++mt)
#pragma unroll
            for (int ks = 0; ks < 4; ++ks) Af[mt][ks] = *(const bf16x8_t*)(Wg + (size_t)(ph * 64 + mt * 16 + fr) * 128 + ks * 32 + fq * 8);
        __syncthreads();
        {
            const int q = tid >> 2, c0 = (tid & 3) * 16;
            u32x4 rv[4][2];
#pragma unroll
            for (int gg = 0; gg < 4; ++gg) { const bf16_t* pv = proj + (row0 + q) * INP + C_SV + gg * 64 + c0; rv[gg][0] = *(const u32x4*)pv; rv[gg][1] = *(const u32x4*)(pv + 8); }
            f32x4 gnv[4][4]; { const float* gn = P.inp(20) + l * SGUW + c0;
#pragma unroll
              for (int gg = 0; gg < 4; ++gg)
#pragma unroll
                  for (int i4 = 0; i4 < 4; ++i4) gnv[gg][i4] = *(const f32x4*)(gn + gg * 64 + i4 * 4); }
            LOADS_ISSUED();
#pragma unroll
            for (int gg = 0; gg < 4; ++gg) {
                const u32x4 r0 = rv[gg][0], r1 = rv[gg][1];
                float v[16] = {bflo(r0.x), bfhi(r0.x), bflo(r0.y), bfhi(r0.y), bflo(r0.z), bfhi(r0.z), bflo(r0.w), bfhi(r0.w), bflo(r1.x), bfhi(r1.x), bflo(r1.y), bfhi(r1.y), bflo(r1.z), bfhi(r1.z), bflo(r1.w), bfhi(r1.w)};
                float ss = 0.f;
#pragma unroll
                for (int i = 0; i < 16; ++i) { v[i] = geluf_(v[i]); ss += v[i] * v[i]; }
                ss += __shfl_xor(ss, 1); ss += __shfl_xor(ss, 2);
                const float rs = rsqrtf(ss * (1.f / 64.f) + EPS);
#pragma unroll
                for (int i = 0; i < 16; ++i) vgT[(gg * 64 + c0 + i) * VGT_P + q] = (bf16_t)f2bf(v[i] * rs * gnv[gg][i >> 2][i & 3]);
            }
        }
        __syncthreads();
        f32x4 acc[4][4];
#pragma unroll
        for (int mt = 0; mt < 4; ++mt)
#pragma unroll
            for (int nt = 0; nt < 4; ++nt) acc[mt][nt] = (f32x4){0.f, 0.f, 0.f, 0.f};
#pragma unroll
        for (int ks = 0; ks < 4; ++ks) { bf16x8_t Bf[4];
#pragma unroll
            for (int nt = 0; nt < 4; ++nt) Bf[nt] = *(const bf16x8_t*)(vgT + (g * 64 + nt * 16 + fr) * VGT_P + ks * 32 + fq * 8);
#pragma unroll
            for (int mt = 0; mt < 4; ++mt)
#pragma unroll
                for (int nt = 0; nt < 4; ++nt) acc[mt][nt] = __builtin_amdgcn_mfma_f32_16x16x32_bf16(Af[mt][ks], Bf[nt], acc[mt][nt], 0, 0, 0); }
        __syncthreads();
#pragma unroll
        for (int mt = 0; mt < 4; ++mt)
#pragma unroll
            for (int reg = 0; reg < 4; ++reg) { const int p = ph * 64 + mt * 16 + fq * 4 + reg; const float bs = P.inp(22)[(l * 4 + g) * CHUNK + p];
#pragma unroll
                for (int nt = 0; nt < 4; ++nt) T[p * SGT_P + g * 64 + nt * 16 + fr] = (bf16_t)f2bf(acc[mt][nt][reg] + bs); }
        __syncthreads();
        u32x2 uwv[16];
#pragma unroll
        for (int tt = 0; tt < 16; ++tt) uwv[tt] = *(const u32x2*)(proj + (row0 + w * 16 + tt) * INP + C_SU + lane * 4);
#pragma unroll
        for (int tt = 0; tt < 16; ++tt) { const int t = w * 16 + tt; const size_t row = row0 + t;
            const u32x2 sw = *(const u32x2*)(T + t * SGT_P + lane * 4); const u32x2 uw = uwv[tt];
            const float v0 = geluf_(bflo(uw.x)) * bflo(sw.x), v1 = geluf_(bfhi(uw.x)) * bfhi(sw.x), v2 = geluf_(bflo(uw.y)) * bflo(sw.y), v3 = geluf_(bfhi(uw.y)) * bfhi(sw.y);
            const float ss = wave_sum(v0 * v0 + v1 * v1 + v2 * v2 + v3 * v3); const float rs = rsqrtf(ss * (1.f / SGUW) + EPS);
            u32x2 o; o.x = pk2(v0 * rs, v1 * rs); o.y = pk2(v2 * rs, v3 * rs);
            *(u32x2*)(mix + row * DM + 768 + lane * 4) = o; }
    }
}

__device__ __forceinline__ void stage_finalize(const Params& P, int bid, int nb, int skipctx) {
    const int lane = TIDX & 63, gw = bid * (NTHR / 64) + (TIDX >> 6), ngw = nb * (NTHR / 64);
    bf16_t* mix = (bf16_t*)(P.ws + WS_H);
    for (int r0 = gw * 4; r0 < NR; r0 += ngw * 4) {
        if (skipctx && (r0 % TPB) < CTXL) continue;
        u32x4 aw[4];
#pragma unroll
        for (int i = 0; i < 4; ++i) aw[i] = *(const u32x4*)(mix + (size_t)(r0 + i) * DM + lane * 8);
#pragma unroll
        for (int i = 0; i < 4; ++i) {
            float a[8] = {bflo(aw[i].x), bfhi(aw[i].x), bflo(aw[i].y), bfhi(aw[i].y), bflo(aw[i].z), bfhi(aw[i].z), bflo(aw[i].w), bfhi(aw[i].w)};
            float s2 = 0.f;
#pragma unroll
            for (int e = 0; e < 8; ++e) s2 += a[e] * a[e];
            s2 = wave_sum(s2); const float r2 = rsqrtf(s2 * (1.f / 512.f) + EPS);
            u32x4 o; o.x = pk2(a[0] * r2, a[1] * r2); o.y = pk2(a[2] * r2, a[3] * r2); o.z = pk2(a[4] * r2, a[5] * r2); o.w = pk2(a[6] * r2, a[7] * r2);
            *(u32x4*)(mix + (size_t)(r0 + i) * DM + lane * 8) = o; }
    }
}

namespace pg8 {
#define PG8_LAS __attribute__((address_space(3)))
typedef unsigned short bf16_t;
typedef short bf16x8 __attribute__((ext_vector_type(8)));
typedef float f32x4 __attribute__((ext_vector_type(4)));
typedef unsigned u32x4 __attribute__((ext_vector_type(4)));
constexpr int BM = 256, BK = 64, HALF = 128, HTB = HALF * BK * 2  , STAGE_BYTES = 8 * HTB, NXCD = 8, WGM = 4;

__host__ __device__ __forceinline__ int lds_byte(int r, int c) { const int st = (r >> 4) * 2 + (c >> 5), rr = r & 15, cc = c & 31, ob = rr * 64 + cc * 2; return st * 1024 + (ob ^ (((ob >> 9) & 1) << 5)); }
__host__ __device__ __forceinline__ void stage_rc(int b, int& R, int& C) { const int st = b / 1024, sb = b % 1024, swz = sb ^ (((sb >> 9) & 1) << 5); R = (st >> 1) * 16 + swz / 64; C = (st & 1) * 32 + (swz % 64) / 2; }
__host__ __device__ __forceinline__ int perm32(int rho) { const int n = rho >> 4, i = rho & 15; return 8 * (i >> 2) + 4 * n + (i & 3); }

struct Unit { int pm, pn; };
struct Gemm { const bf16_t* A; const bf16_t* Bt; int M, N, K, lda; int pn_split = 1 << 30, a_off2 = 0, pm_div9 = 0; };

struct StaticOrder {
    int nM, nN, nwg, G, c, skip, nsc, nss;
    __host__ __device__ void init(int M, int N, int G_, int c_, int skip_ = 0, int nsc_ = 0, int nss_ = 0) {
        skip = skip_; nM = skip == 1 ? 128 : (skip == 2 ? 16 : M / BM); nN = N / BM; nwg = nM * nN; G = G_; c = c_; nsc = nsc_; nss = nss_; }
    __host__ __device__ bool next(int i, Unit& u) const {
        const int R = i + (c < nsc ? nss : 0);
        const long L = (long)R * G + c - (long)nsc * (R < nss ? R + 1 : nss); if (L >= nwg) return false;
        int wgid = (int)L; { const int q = nwg / NXCD, r = nwg % NXCD, xcd = wgid % NXCD, off = wgid / NXCD; wgid = (xcd < r ? xcd * (q + 1) : r * (q + 1) + (xcd - r) * q) + off; }
        const int nig = WGM * nN, gid = wgid / nig, fm = gid * WGM, gsz = (nM - fm) < WGM ? (nM - fm) : WGM;
        u.pm = fm + ((wgid % nig) % gsz); u.pn = (wgid % nig) / gsz;
        if (skip == 1) u.pm = (u.pm >> 3) * 9 + 1 + (u.pm & 7); else if (skip == 2) u.pm = u.pm * 9;
        return true;
    }
    __device__ __forceinline__ void a_ready(const Unit&) const {}
    __device__ __forceinline__ void done(const Unit&) const {}
};

template <class Epi, class Sched, bool ALIGN_EPI = false, bool SP2 = false>
__device__ __forceinline__ void gemm_phase(PG8_LAS unsigned char* lds, const Gemm g, const Sched& S, const Epi& E) {
    const int tid = TIDX, wid = __builtin_amdgcn_readfirstlane(tid >> 6), lane = tid & 63, wr = wid >> 2, wc = wid & 3, fr = lane & 15, fq = lane >> 4;
    const int K = g.K, nt = K / BK;
    unsigned voffA[2], voffB[2];
#pragma unroll
    for (int i = 0; i < 2; ++i) { int R, C; stage_rc(tid * 16 + i * 8192, R, C); const int Rb = Epi::PERM ? ((R & ~31) + perm32(R & 31)) : R;
        voffA[i] = (unsigned)(R * g.lda + C) * 2u; voffB[i] = (unsigned)(Rb * K + C) * 2u; }
    const size_t kstep = (size_t)(BK * 2);
    const size_t hstepA = (size_t)HALF * g.lda * 2, hstepB = (size_t)HALF * K * 2;
    const size_t tstepA = 2 * hstepA, tstepB = 2 * hstepB;
    const unsigned ldsw = (unsigned)wid * 1024u;
    const int aoff = lds_byte(wr * 64 + fr, fq * 8), boff = lds_byte(wc * 32 + fr, fq * 8);
#define PG8_SA(b, h) (((b) * 2 + (h)) * HTB)
#define PG8_SB(b, h) ((4 + (b) * 2 + (h)) * HTB)
#define PG8_STAGE(bufoff, gbase, voff) do { _Pragma("unroll") for (int _i = 0; _i < 2; ++_i) \
        __builtin_amdgcn_global_load_lds((const unsigned*)((const char*)(gbase) + (voff)[_i]), (PG8_LAS unsigned*)(lds + (bufoff) + ldsw + _i * 8192), 16, 0, 0); } while (0)
#define PG8_LDA(dst, b, h) do { _Pragma("unroll") for (int m = 0; m < 4; ++m) _Pragma("unroll") for (int k = 0; k < 2; ++k) dst[m][k] = *(const PG8_LAS bf16x8*)(lds + PG8_SA(b, h) + aoff + m * 2048 + k * 1024); } while (0)
#define PG8_LDB(dst, b, h) do { _Pragma("unroll") for (int n = 0; n < 2; ++n) _Pragma("unroll") for (int k = 0; k < 2; ++k) dst[n][k] = *(const PG8_LAS bf16x8*)(lds + PG8_SB(b, h) + boff + n * 2048 + k * 1024); } while (0)
#define PG8_MMA(ai, bj, At, Bt) do { __builtin_amdgcn_s_setprio(1); _Pragma("unroll") for (int m = 0; m < 4; ++m) _Pragma("unroll") for (int n = 0; n < 2; ++n) _Pragma("unroll") for (int k = 0; k < 2; ++k) \
        acc[ai][bj][m][n] = __builtin_amdgcn_mfma_f32_16x16x32_bf16(Bt[n][k], At[m][k], acc[ai][bj][m][n], 0, 0, 0); __builtin_amdgcn_s_setprio(0); } while (0)
#define PG8_WAIT_V(n) asm volatile("s_waitcnt vmcnt(" #n ")" ::: "memory")
#define PG8_WAIT_L(n) asm volatile("s_waitcnt lgkmcnt(" #n ")" ::: "memory")
#define PG8_BAR __builtin_amdgcn_s_barrier()
#define PG8_SCHED __builtin_amdgcn_sched_barrier(0)
    Unit cur, nxt; int ui = 0;
    if (!S.next(0, cur)) return;
    f32x4 acc[2][2][4][2];
#pragma unroll
    for (int a = 0; a < 2; ++a)
#pragma unroll
        for (int b = 0; b < 2; ++b)
#pragma unroll
            for (int m = 0; m < 4; ++m)
#pragma unroll
                for (int n = 0; n < 2; ++n) acc[a][b][m][n] = (f32x4){0.f, 0.f, 0.f, 0.f};
    bf16x8 At[4][2], B0[2][2], B1[2][2];
    const char* cA = (const char*)g.A + (size_t)(g.pm_div9 ? cur.pm / 9 : cur.pm) * tstepA + (cur.pn >= g.pn_split ? (size_t)g.a_off2 * 2 : 0); const char* cB = (const char*)g.Bt + (size_t)cur.pn * tstepB;
    S.a_ready(cur);
    if constexpr (SP2) {
        PG8_STAGE(PG8_SB(0, 0), cB, voffB); PG8_STAGE(PG8_SB(0, 1), cB + hstepB, voffB); PG8_STAGE(PG8_SA(0, 0), cA, voffA); PG8_STAGE(PG8_SA(0, 1), cA + hstepA, voffA);
        if (wr == 1) PG8_BAR;
        PG8_WAIT_V(2); PG8_BAR;
        PG8_STAGE(PG8_SB(1, 0), cB + kstep, voffB); PG8_STAGE(PG8_SA(1, 0), cA + kstep, voffA); PG8_STAGE(PG8_SB(1, 1), cB + hstepB + kstep, voffB);
        PG8_WAIT_V(6); PG8_BAR;
    } else {
        PG8_STAGE(PG8_SB(0, 0), cB, voffB); PG8_STAGE(PG8_SA(0, 0), cA, voffA); PG8_STAGE(PG8_SB(0, 1), cB + hstepB, voffB); PG8_STAGE(PG8_SA(0, 1), cA + hstepA, voffA);
        if (wr == 1) PG8_BAR;
        PG8_WAIT_V(4); PG8_BAR;
        PG8_STAGE(PG8_SB(1, 0), cB + kstep, voffB); PG8_STAGE(PG8_SA(1, 0), cA + kstep, voffA); PG8_STAGE(PG8_SB(1, 1), cB + hstepB + kstep, voffB);
        PG8_WAIT_V(6); PG8_BAR;
    }
    for (;;) {
        const bool has_next = S.next(ui + 1, nxt);
        const char* nA = has_next ? (const char*)g.A + (size_t)(g.pm_div9 ? nxt.pm / 9 : nxt.pm) * tstepA + (nxt.pn >= g.pn_split ? (size_t)g.a_off2 * 2 : 0) : cA; const char* nB = has_next ? (const char*)g.Bt + (size_t)nxt.pn * tstepB : cB;
        for (int t = 0; t < nt; t += 2) {
            const bool last = (t == nt - 2);
            const char* a1 = cA + (size_t)(t + 1) * kstep;
            const char* a2 = last ? nA : cA + (size_t)(t + 2) * kstep; const char* b2 = last ? nB : cB + (size_t)(t + 2) * kstep;
            const char* a3 = a2 + kstep; const char* b3 = b2 + kstep;
            if (last && has_next) S.a_ready(nxt);
            if constexpr (SP2) {
            PG8_LDB(B0, 0, 0); PG8_LDB(B1, 0, 1); PG8_SCHED; PG8_LDA(At, 0, 0); PG8_STAGE(PG8_SA(1, 1), a1 + hstepA, voffA);
            PG8_WAIT_V(8); PG8_WAIT_L(0); PG8_BAR; PG8_MMA(0, 0, At, B0); PG8_MMA(0, 1, At, B1); PG8_BAR; PG8_SCHED;
            PG8_LDA(At, 0, 1); PG8_STAGE(PG8_SB(0, 0), b2, voffB); PG8_STAGE(PG8_SB(0, 1), b2 + hstepB, voffB); PG8_STAGE(PG8_SA(0, 0), a2, voffA);
            PG8_WAIT_V(8); PG8_WAIT_L(0); PG8_BAR; PG8_MMA(1, 0, At, B0); PG8_MMA(1, 1, At, B1); PG8_BAR; PG8_SCHED;
            PG8_LDB(B0, 1, 0); PG8_LDB(B1, 1, 1); PG8_SCHED; PG8_LDA(At, 1, 0); PG8_STAGE(PG8_SA(0, 1), a2 + hstepA, voffA);
            PG8_WAIT_V(8); PG8_WAIT_L(0); PG8_BAR; PG8_MMA(0, 0, At, B0); PG8_MMA(0, 1, At, B1); PG8_BAR; PG8_SCHED;
            PG8_LDA(At, 1, 1); PG8_STAGE(PG8_SB(1, 0), b3, voffB); PG8_STAGE(PG8_SB(1, 1), b3 + hstepB, voffB); PG8_STAGE(PG8_SA(1, 0), a3, voffA);
            PG8_WAIT_V(8); PG8_WAIT_L(0); PG8_BAR; PG8_MMA(1, 0, At, B0); PG8_MMA(1, 1, At, B1); PG8_BAR; PG8_SCHED;
            } else {
            PG8_LDB(B0, 0, 0); PG8_SCHED; PG8_LDA(At, 0, 0); PG8_STAGE(PG8_SA(1, 1), a1 + hstepA, voffA);
            PG8_WAIT_L(8); PG8_BAR; PG8_WAIT_L(0); PG8_MMA(0, 0, At, B0); PG8_BAR; PG8_SCHED;
            PG8_LDB(B1, 0, 1); PG8_STAGE(PG8_SB(0, 0), b2, voffB);
            PG8_BAR; PG8_WAIT_L(0); PG8_MMA(0, 1, At, B1); PG8_BAR;
            PG8_LDA(At, 0, 1); PG8_STAGE(PG8_SA(0, 0), a2, voffA);
            PG8_BAR; PG8_WAIT_L(0); PG8_MMA(1, 0, At, B0); PG8_BAR; PG8_SCHED;
            PG8_STAGE(PG8_SB(0, 1), b2 + hstepB, voffB);
            PG8_WAIT_V(6); PG8_BAR; PG8_MMA(1, 1, At, B1); PG8_BAR;
            PG8_LDB(B0, 1, 0); PG8_SCHED; PG8_LDA(At, 1, 0); PG8_STAGE(PG8_SA(0, 1), a2 + hstepA, voffA);
            PG8_WAIT_L(8); PG8_BAR; PG8_WAIT_L(0); PG8_MMA(0, 0, At, B0); PG8_BAR; PG8_SCHED;
            PG8_LDB(B1, 1, 1); PG8_STAGE(PG8_SB(1, 0), b3, voffB);
            PG8_BAR; PG8_WAIT_L(0); PG8_MMA(0, 1, At, B1); PG8_BAR;
            PG8_LDA(At, 1, 1); PG8_STAGE(PG8_SA(1, 0), a3, voffA);
            PG8_BAR; PG8_WAIT_L(0); PG8_MMA(1, 0, At, B0); PG8_BAR; PG8_SCHED;
            PG8_STAGE(PG8_SB(1, 1), b3 + hstepB, voffB);
            PG8_WAIT_V(6); PG8_BAR; PG8_MMA(1, 1, At, B1); PG8_BAR;
            }
        }
        if constexpr (ALIGN_EPI) { if (wr == 0) PG8_BAR; }
        if constexpr (!Epi::AFTER_DRAIN) { E(acc, cur, wr, wc, fr, fq); S.done(cur); }
        if (!has_next) break;
#pragma unroll
        for (int a = 0; a < 2; ++a)
#pragma unroll
            for (int b = 0; b < 2; ++b)
#pragma unroll
                for (int m = 0; m < 4; ++m)
#pragma unroll
                    for (int n = 0; n < 2; ++n) acc[a][b][m][n] = (f32x4){0.f, 0.f, 0.f, 0.f};
        cur = nxt; cA = nA; cB = nB; ++ui;
        if constexpr (ALIGN_EPI) { if (wr == 1) PG8_BAR; }
    }
    PG8_WAIT_V(0);
    if constexpr (!ALIGN_EPI) { if (wr == 0) PG8_BAR; }
    PG8_BAR;
    if constexpr (Epi::AFTER_DRAIN) { E.fused(acc, cur, wr, wc, fr, fq, lds, wid, lane); S.done(cur); }
#undef PG8_SA
#undef PG8_SB
#undef PG8_STAGE
#undef PG8_LDA
#undef PG8_LDB
#undef PG8_MMA
#undef PG8_WAIT_V
#undef PG8_WAIT_L
#undef PG8_BAR
#undef PG8_SCHED
}
}

using pg8::Unit;
__device__ __forceinline__ unsigned cvt_pk_bf16(float lo, float hi) { unsigned r; asm volatile("v_cvt_pk_bf16_f32 %0, %1, %2" : "=v"(r) : "v"(lo), "v"(hi)); return r; }
struct EpiBf16S {
    static constexpr bool PERM = true, AFTER_DRAIN = false;
    bf16_t* O; int ldc; const float* rowscale;
    __device__ __forceinline__ void operator()(const pg8::f32x4 (&acc)[2][2][4][2], const Unit& u, int wr, int wc, int fr, int fq) const {
        { const int ln = TIDX & 63; fr = ln & 15; fq = ln >> 4; }
        const int row0 = u.pm * 256 + wr * 64 + fr, col0 = u.pn * 256 + wc * 32 + 8 * fq;
#pragma unroll
        for (int ai = 0; ai < 2; ++ai)
#pragma unroll
            for (int m = 0; m < 4; ++m) { const int r = row0 + ai * 128 + m * 16; const float s = rowscale ? rowscale[r] : 1.f; bf16_t* rowp = O + (size_t)r * ldc + col0;
#pragma unroll
                for (int bj = 0; bj < 2; ++bj) { const pg8::f32x4 v0 = acc[ai][bj][m][0] * s, v1 = acc[ai][bj][m][1] * s;
                    u32x4 w; w.x = cvt_pk_bf16(v0[0], v0[1]); w.y = cvt_pk_bf16(v0[2], v0[3]); w.z = cvt_pk_bf16(v1[0], v1[1]); w.w = cvt_pk_bf16(v1[2], v1[3]);
                    *(u32x4*)(rowp + bj * 128) = w; } }
    }
};
struct EpiQKV {
    static constexpr bool PERM = true, AFTER_DRAIN = false;
    bf16_t* Oq; bf16_t* Okv;
    __device__ __forceinline__ void operator()(const f32x4 (&acc)[2][2][4][2], const Unit& u, int wr, int wc, int fr, int fq) const {
        { const int ln = TIDX & 63; fr = ln & 15; fq = ln >> 4; }
        const bool isq = u.pn < 3; bf16_t* O = isq ? Oq : Okv; const int ldc = isq ? QW : KVW;
        const int row0 = u.pm * 256 + wr * 64 + fr, col0 = (isq ? u.pn : u.pn - 3) * 256 + wc * 32 + 8 * fq;
#pragma unroll
        for (int ai = 0; ai < 2; ++ai)
#pragma unroll
            for (int m = 0; m < 4; ++m) { bf16_t* rowp = O + (size_t)(row0 + ai * 128 + m * 16) * ldc + col0;
#pragma unroll
                for (int bj = 0; bj < 2; ++bj) { const f32x4 v0 = acc[ai][bj][m][0], v1 = acc[ai][bj][m][1];
                    u32x4 w; w.x = cvt_pk_bf16(v0[0], v0[1]); w.y = cvt_pk_bf16(v0[2], v0[3]); w.z = cvt_pk_bf16(v1[0], v1[1]); w.w = cvt_pk_bf16(v1[2], v1[3]);
                    *(u32x4*)(rowp + bj * 128) = w; } }
    }
};
struct EpiProj {
    static constexpr bool PERM = true, AFTER_DRAIN = false;
    bf16_t* O; const float* rowss; const float* shw  ;
    __device__ __forceinline__ void operator()(const f32x4 (&acc)[2][2][4][2], const Unit& u, int wr, int wc, int fr, int fq) const {
        { const int ln = TIDX & 63; fr = ln & 15; fq = ln >> 4; }
        const int bt = u.pm / 9, jt = u.pm - bt * 9; const int mr = jt == 0 ? 16 : bt;
        const int row0 = u.pm * 256 + wr * 64 + fr, col0 = u.pn * 256 + wc * 32 + 8 * fq;
        float rr[8];
#pragma unroll
        for (int i = 0; i < 8; ++i) rr[i] = rsqrtf(rowss[row0 + (i >> 2) * 128 + (i & 3) * 16] * (1.f / DM) + EPS);
#pragma unroll
        for (int bj = 0; bj < 2; ++bj) { const float* sp = shw + (size_t)mr * 7168 + col0 + bj * 128; const f32x4 b0 = *(const f32x4*)sp, b1 = *(const f32x4*)(sp + 4);
#pragma unroll
            for (int ai = 0; ai < 2; ++ai)
#pragma unroll
                for (int m = 0; m < 4; ++m) { const float s = rr[ai * 4 + m]; const f32x4 v0 = acc[ai][bj][m][0] * s + b0, v1 = acc[ai][bj][m][1] * s + b1;
                    u32x4 w; w.x = cvt_pk_bf16(v0[0], v0[1]); w.y = cvt_pk_bf16(v0[2], v0[3]); w.z = cvt_pk_bf16(v1[0], v1[1]); w.w = cvt_pk_bf16(v1[2], v1[3]);
                    *(u32x4*)(O + (size_t)(row0 + ai * 128 + m * 16) * INP + col0 + bj * 128) = w; }
            asm volatile("" ::: "memory"); }
    }
};
struct EpiRes2 {
    static constexpr bool PERM = true, AFTER_DRAIN = false;
    GAS1 float* out; GAS1 unsigned char* ws; int l, gch; const float* gs  ; bf16_t* XB; float* rowss; const float* rd_lat; const float* rd_ctx;
    __device__ __forceinline__ void operator()(const f32x4 (&acc)[2][2][4][2], const Unit& u, int wr, int wc, int fr, int fq) const {
        { const int ln = TIDX & 63; fr = ln & 15; fq = ln >> 4; }
        const int b = u.pm / 9, j = u.pm - b * 9; const bool isctx = (j == 0); const int mr = isctx ? 16 : b;
        float* res0 = isctx ? (float*)(ws + WS_CRES) + (size_t)(b * CTXL) * DM : (float*)(out + (size_t)(b * SEQ + (j - 1) * 256) * DM);
        const float* gate = (const float*)(ws + WS_MOD) + ((size_t)(l * 17 + mr)) * 6144 + gch * 1024;
        const int col0 = u.pn * 256 + wc * 32 + 8 * fq, rloc = wr * 64 + fr;
        const float* rd0 = rd_lat ? (isctx ? rd_ctx + (size_t)(b * CTXL) * DM : rd_lat + (size_t)(b * SEQ + (j - 1) * 256) * DM) : res0;
        float ss[8];
#pragma unroll
        for (int i = 0; i < 8; ++i) ss[i] = 0.f;
        u32x4 pk[2][2][4];
#pragma unroll
        for (int ai = 0; ai < 2; ++ai)
#pragma unroll
            for (int bj = 0; bj < 2; ++bj)
#pragma unroll
                for (int m = 0; m < 4; ++m) { const f32x4 a0 = acc[ai][bj][m][0], a1 = acc[ai][bj][m][1];
                    pk[ai][bj][m] = (u32x4){cvt_pk_bf16(a0.x, a0.y), cvt_pk_bf16(a0.z, a0.w), cvt_pk_bf16(a1.x, a1.y), cvt_pk_bf16(a1.z, a1.w)}; }
        asm volatile("" ::: "memory");
#pragma unroll
        for (int bj = 0; bj < 2; ++bj) { const int cc = col0 + bj * 128; const f32x4 g0 = *(const f32x4*)(gate + cc), g1 = *(const f32x4*)(gate + cc + 4); f32x4 s0 = g0, s1 = g1;
            if (gs) { s0 = *(const f32x4*)(gs + mr * 1024 + cc); s1 = *(const f32x4*)(gs + mr * 1024 + cc + 4); }
            f32x4 x0[8], x1[8];
#pragma unroll
            for (int i = 0; i < 8; ++i) { const float* pr = rd0 + (size_t)(rloc + (i >> 2) * 128 + (i & 3) * 16) * DM + cc; x0[i] = *(const f32x4*)pr; x1[i] = *(const f32x4*)(pr + 4); }
            LOADS_ISSUED();
#pragma unroll
            for (int ai = 0; ai < 2; ++ai)
#pragma unroll
                for (int m = 0; m < 4; ++m) { const int rl = rloc + ai * 128 + m * 16; float* p = res0 + (size_t)rl * DM + cc; const u32x4 q = pk[ai][bj][m];
                    f32x4 o0 = x0[ai * 4 + m], o1 = x1[ai * 4 + m];
                    o0 += g0 * (f32x4){bflo(q.x), bfhi(q.x), bflo(q.y), bfhi(q.y)}; o1 += g1 * (f32x4){bflo(q.z), bfhi(q.z), bflo(q.w), bfhi(q.w)}; *(f32x4*)p = o0; *(f32x4*)(p + 4) = o1;
                    if (gs) { ss[ai * 4 + m] += (o0.x * o0.x + o0.y * o0.y + o0.z * o0.z + o0.w * o0.w) + (o1.x * o1.x + o1.y * o1.y + o1.z * o1.z + o1.w * o1.w);
                        const f32x4 y0 = o0 * s0, y1 = o1 * s1; u32x4 w; w.x = cvt_pk_bf16(y0.x, y0.y); w.y = cvt_pk_bf16(y0.z, y0.w); w.z = cvt_pk_bf16(y1.x, y1.y); w.w = cvt_pk_bf16(y1.z, y1.w);
                        *(u32x4*)(XB + (size_t)(u.pm * 256 + rl) * DM + cc) = w; } }
            asm volatile("" ::: "memory"); }
        if (gs) {
#pragma unroll
            for (int i = 0; i < 8; ++i) { float t = ss[i]; t += __shfl_xor(t, 16); t += __shfl_xor(t, 32);
                if (fq == 0) atomicAdd(rowss + u.pm * 256 + rloc + (i >> 2) * 128 + (i & 3) * 16, t); } }
    }
};
struct EpiSwiglu2 {
    static constexpr bool PERM = true, AFTER_DRAIN = false;
    bf16_t* O; bf16_t* Octx; const float* rowss; const float* shw  ;
    __device__ __forceinline__ void operator()(const f32x4 (&acc)[2][2][4][2], const Unit& u, int wr, int wc, int fr, int fq) const {
        { const int ln = TIDX & 63; fr = ln & 15; fq = ln >> 4; }
        const int bt = u.pm / 9, jt = u.pm - bt * 9; const int mr = jt == 0 ? 16 : bt;
        const int row0 = u.pm * 256 + wr * 64 + fr, col0 = u.pn * 128 + wc * 32 + 8 * fq;
        bf16_t* Ob = jt == 0 ? Octx + (size_t)(bt * 256 + wr * 64 + fr) * DFF : O + (size_t)row0 * DFF;
        const float* sp = shw + (size_t)mr * 7168 + u.pn * 256 + wc * 32 + 8 * fq;
        const f32x4 bg0 = *(const f32x4*)sp, bg1 = *(const f32x4*)(sp + 4), bu0 = *(const f32x4*)(sp + 128), bu1 = *(const f32x4*)(sp + 132);
#pragma unroll
        for (int ai = 0; ai < 2; ++ai)
#pragma unroll
            for (int m = 0; m < 4; ++m) { const int r = row0 + ai * 128 + m * 16; const float s = rsqrtf(rowss[r] * (1.f / DM) + EPS);
                const f32x4 g0 = acc[ai][0][m][0] * s + bg0, g1 = acc[ai][0][m][1] * s + bg1, u0 = acc[ai][1][m][0] * s + bu0, u1 = acc[ai][1][m][1] * s + bu1; float o[8];
#pragma unroll
                for (int i = 0; i < 4; ++i) { o[i] = g0[i] * u0[i] * __builtin_amdgcn_rcpf(1.f + __builtin_amdgcn_exp2f(-1.4426950408889634f * g0[i]));
                                              o[4 + i] = g1[i] * u1[i] * __builtin_amdgcn_rcpf(1.f + __builtin_amdgcn_exp2f(-1.4426950408889634f * g1[i])); }
                u32x4 w; w.x = cvt_pk_bf16(o[0], o[1]); w.y = cvt_pk_bf16(o[2], o[3]); w.z = cvt_pk_bf16(o[4], o[5]); w.w = cvt_pk_bf16(o[6], o[7]);
                *(u32x4*)(Ob + (size_t)(ai * 128 + m * 16) * DFF + col0) = w; }
    }
};

namespace attn {
using bf16x8 = __attribute__((ext_vector_type(8))) short;
using s16x4  = __attribute__((ext_vector_type(4))) short;
using f32x16 = __attribute__((ext_vector_type(16))) float;
constexpr int NW = 8, QBLK = 32, KVBLK = 64;
constexpr float SCALE = 0.10206207261596575f;
constexpr float THR = 8.f;
constexpr int SHM_K = 64 * 256, SHM_V = 64 * 64 * 2, NBUF = 3, SHM_ATTN = NBUF * SHM_V + NBUF * SHM_K + NW * 64 * 4;
#define KSWZ(row, colB) ((row) * 256 + ((colB) ^ (((row) & 7) << 4)))
#define SBAR() __builtin_amdgcn_sched_barrier(0)
__device__ __forceinline__ int crow(int r, int hi) { return (r & 3) + 8 * (r >> 2) + 4 * hi; }
__device__ __forceinline__ unsigned cvtpk(float lo, float hi) { unsigned r; asm volatile("v_cvt_pk_bf16_f32 %0, %1, %2" : "=v"(r) : "v"(lo), "v"(hi)); return r; }
constexpr float THRL = THR * 1.4426950408889634f;
__device__ __forceinline__ void partialSM(f32x16& p0, f32x16& p1, float& mhat, float& alpha, f32x16& negm, bool first) {
  float pmax = p0[0];
#pragma unroll
  for (int r = 1; r < 16; ++r) pmax = fmaxf(pmax, p0[r]);
#pragma unroll
  for (int r = 0; r < 16; ++r) pmax = fmaxf(pmax, p1[r]);
  { auto rr = __builtin_amdgcn_permlane32_swap(__float_as_uint(pmax), __float_as_uint(pmax), false, false);
    pmax = fmaxf(__uint_as_float(rr[0]), __uint_as_float(rr[1])); }
  alpha = 1.f;
  if (__builtin_expect(first || !__all(pmax <= THRL), 0)) {
    const float dl = first ? pmax : fmaxf(pmax, 0.f); mhat += dl;
#pragma unroll
    for (int r = 0; r < 16; ++r) { p0[r] -= dl; p1[r] -= dl; }
#pragma unroll
    for (int r = 0; r < 16; ++r) negm[r] = -mhat;
    if (!first) alpha = __builtin_amdgcn_exp2f(-dl);
  }
#pragma unroll
  for (int r = 0; r < 16; ++r) p0[r] = __builtin_amdgcn_exp2f(p0[r]);
}
__device__ __forceinline__ void finishSM(f32x16& p0, f32x16& p1, float alpha, float& l_reg, bf16x8& pa0, bf16x8& pa1, bf16x8& pa2, bf16x8& pa3) {
#pragma unroll
  for (int r = 0; r < 16; ++r) p1[r] = __builtin_amdgcn_exp2f(p1[r]);
  float ps = 0;
#pragma unroll
  for (int r = 0; r < 16; ++r) ps += p0[r];
#pragma unroll
  for (int r = 0; r < 16; ++r) ps += p1[r];
  { auto rr = __builtin_amdgcn_permlane32_swap(__float_as_uint(ps), __float_as_uint(ps), false, false);
    ps = __uint_as_float(rr[0]) + __uint_as_float(rr[1]); }
  l_reg = l_reg * alpha + ps;
#define PK4(P, BASE, OUT) do { unsigned a0 = cvtpk(P[BASE + 0], P[BASE + 1]), a1 = cvtpk(P[BASE + 2], P[BASE + 3]);   \
    unsigned b0 = cvtpk(P[BASE + 4], P[BASE + 5]), b1 = cvtpk(P[BASE + 6], P[BASE + 7]);                              \
    auto r0 = __builtin_amdgcn_permlane32_swap(a0, b0, false, false); auto r1 = __builtin_amdgcn_permlane32_swap(a1, b1, false, false); \
    u32x4 w = {r0[0], r1[0], r0[1], r1[1]}; OUT = *reinterpret_cast<bf16x8*>(&w); } while (0)
  PK4(p0, 0, pa0); PK4(p0, 8, pa1); PK4(p1, 0, pa2); PK4(p1, 8, pa3);
#undef PK4
}
__device__ __forceinline__ void qkt(f32x16& p0, f32x16& p1, const char* Ks, const bf16x8* qr, const f32x16& negm, int r32, int hi) {
  p0 = negm; p1 = negm;
#pragma unroll
  for (int d0 = 0; d0 < 6; ++d0) { int cb = (d0 * 16 + hi * 8) * 2;
    bf16x8 b0 = *reinterpret_cast<const bf16x8*>(Ks + KSWZ(r32, cb));
    bf16x8 b1 = *reinterpret_cast<const bf16x8*>(Ks + KSWZ(32 + r32, cb));
    p0 = __builtin_amdgcn_mfma_f32_32x32x16_bf16(b0, qr[d0], p0, 0, 0, 0);
    p1 = __builtin_amdgcn_mfma_f32_32x32x16_bf16(b1, qr[d0], p1, 0, 0, 0); }
}
__device__ __forceinline__ int v_st(int k, int c) { const int kk = (k & ~0xC) | ((k & 4) << 1) | ((k & 8) >> 1); return ((kk >> 3) * 2 + (c >> 5)) * 512 + ((kk & 7) * 32 + (c & 31)) * 2; }
__device__ __forceinline__ int v_rd_base(int lane) { return ((lane & 3) << 3) | (((lane >> 2) & 3) << 6) | (((lane >> 4) & 1) << 5) | (((lane >> 5) & 1) << 8); }
constexpr int v_rd_off(int d0, int ks, int half) { return d0 * 512 + ks * 2048 + half * 1024; }
template <int OFF> __device__ __forceinline__ s16x4 tr_read(int vb) {
  s16x4 r; asm volatile("ds_read_b64_tr_b16 %0, %1 offset:%2" : "=&v"(r) : "v"(vb), "i"(OFF) : "memory"); return r;
}
template <int D0> __device__ __forceinline__ void pv_one(f32x16& od, int vb, bf16x8 pa0, bf16x8 pa1, bf16x8 pa2, bf16x8 pa3) {
  const s16x4 l0 = tr_read<v_rd_off(D0, 0, 0)>(vb), h0 = tr_read<v_rd_off(D0, 0, 1)>(vb), l1 = tr_read<v_rd_off(D0, 1, 0)>(vb), h1 = tr_read<v_rd_off(D0, 1, 1)>(vb);
  const s16x4 l2 = tr_read<v_rd_off(D0, 2, 0)>(vb), h2 = tr_read<v_rd_off(D0, 2, 1)>(vb), l3 = tr_read<v_rd_off(D0, 3, 0)>(vb), h3 = tr_read<v_rd_off(D0, 3, 1)>(vb);
  asm volatile("s_waitcnt lgkmcnt(0)" ::: "memory"); SBAR();
#define PK(L, H) (bf16x8){L[0], L[1], L[2], L[3], H[0], H[1], H[2], H[3]}
  od = __builtin_amdgcn_mfma_f32_32x32x16_bf16(pa0, PK(l0, h0), od, 0, 0, 0);
  od = __builtin_amdgcn_mfma_f32_32x32x16_bf16(pa1, PK(l1, h1), od, 0, 0, 0);
  od = __builtin_amdgcn_mfma_f32_32x32x16_bf16(pa2, PK(l2, h2), od, 0, 0, 0);
  od = __builtin_amdgcn_mfma_f32_32x32x16_bf16(pa3, PK(l3, h3), od, 0, 0, 0);
#undef PK
}
__device__ __forceinline__ void pv_d0(f32x16* o, int vb, bf16x8 pa0, bf16x8 pa1, bf16x8 pa2, bf16x8 pa3) {
  pv_one<0>(o[0], vb, pa0, pa1, pa2, pa3); pv_one<1>(o[1], vb, pa0, pa1, pa2, pa3);
}
__device__ __forceinline__ void attn_unit(const bf16_t* __restrict__ Qb, const bf16_t* __restrict__ KVb, const bf16_t* __restrict__ KRb, bf16_t* __restrict__ Ob, int seq, char* lds,
                                          int pos0  , const float* __restrict__ tab) {
  const int tid = TIDX, wid = tid >> 6, lane = tid & 63, r32 = lane & 31, hi = lane >> 5;
  char* V_lds = lds; char* K_lds = lds + NBUF * SHM_V;
  float* ws = (float*)(lds + NBUF * SHM_V + NBUF * SHM_K) + wid * 64; float* li_l = ws; float* al_l = ws + 32;
  float mhat = 0.f, l_reg = 0; f32x16 o[2] = {}; bf16x8 qr[6]; f32x16 negm = {};
  const bf16_t* Qw = Qb + (long)(wid * QBLK + r32) * QW + hi * 8;
#pragma unroll
  for (int d0 = 0; d0 < 6; ++d0) qr[d0] = *reinterpret_cast<const bf16x8*>(Qw + d0 * 16);
  if (pos0 >= 0) {
    const int pos = pos0 + wid * QBLK + r32;
#pragma unroll
    for (int dd = 0; dd < 2; ++dd) { const int pp = dd == 0 ? (pos >> 6) : (pos & 63); const float* ct = tab + pp * 8; const float* st = tab + 512 + pp * 8;
      bf16x8 v = qr[4 + dd]; bf16x8 o;
#pragma unroll
      for (int j = 0; j < 8; ++j) { const float x = bf2f((unsigned short)v[j]); const float pr = __shfl_xor(x, 32); const float rot = hi ? pr : -pr;
        o[j] = (short)f2bf(x * ct[j] + rot * st[j]); }
      qr[4 + dd] = o; }
  }
  { constexpr float C = SCALE * 1.4426950408889634f;
#pragma unroll
    for (int d0 = 0; d0 < 6; ++d0) { bf16x8 v = qr[d0];
#pragma unroll
      for (int j = 0; j < 8; ++j) v[j] = (short)f2bf(bf2f((unsigned short)v[j]) * C);
      qr[d0] = v; } }
  const int sr = tid >> 4, c16 = tid & 15;
  const bool kfromkv = c16 < 8; const int kc = c16 < 12 ? c16 : 8;
  const bf16_t* kp0 = kfromkv ? KVb + (long)sr * KVW + kc * 8 : KRb + (long)sr * DROPE + (kc - 8) * 8;
  const long kstr = kfromkv ? KVW : DROPE;
  const bf16_t* vp0 = KVb + (long)sr * KVW + DNOPE + (c16 & 7) * 8;
  const int vst0 = v_st(sr, (c16 & 7) * 8), vst1 = v_st(32 + sr, (c16 & 7) * 8);
  const int kst0 = KSWZ(sr, kc * 16), kst1 = KSWZ(32 + sr, kc * 16);
  const bool kwr = c16 < 12, vwr = c16 < 8;
  const int vb0 = (int)(uintptr_t)V_lds + v_rd_base(lane);
  struct { bf16x8 vs0, vs1, ks0, ks1; } sr_[2];
#define SLOAD(i, k0) do { sr_[i].vs0 = *reinterpret_cast<const bf16x8*>(vp0 + (long)(k0) * KVW); sr_[i].vs1 = *reinterpret_cast<const bf16x8*>(vp0 + (long)((k0) + 32) * KVW); \
    sr_[i].ks0 = *reinterpret_cast<const bf16x8*>(kp0 + (long)(k0) * kstr); sr_[i].ks1 = *reinterpret_cast<const bf16x8*>(kp0 + (long)((k0) + 32) * kstr); } while (0)
#define SWRITE(b, i) do { if (vwr) { *(bf16x8*)(V_lds + (b) * SHM_V + vst0) = sr_[i].vs0; *(bf16x8*)(V_lds + (b) * SHM_V + vst1) = sr_[i].vs1; } \
    if (kwr) { *(bf16x8*)(K_lds + (b) * SHM_K + kst0) = sr_[i].ks0; *(bf16x8*)(K_lds + (b) * SHM_K + kst1) = sr_[i].ks1; } } while (0)
#define SWAIT() asm volatile("s_waitcnt vmcnt(4)" ::: "memory")
#define RESC(a) do { if (__any((a) < 1.f)) { if (hi == 0) al_l[r32] = (a); asm volatile("s_waitcnt lgkmcnt(0)" ::: "memory"); \
    _Pragma("unroll") for (int d = 0; d < 2; ++d) _Pragma("unroll") for (int r = 0; r < 16; ++r) o[d][r] *= al_l[crow(r, hi)]; } } while (0)
  f32x16 pA0, pA1, pB0, pB1; float alA, alB; bf16x8 pa0, pa1, pa2, pa3; const int NT = seq / KVBLK;
  constexpr int SE = 0, SO = 1;
  int i0 = 0, i1 = 1, i2 = 2;
#define ROT3() do { const int t_ = i0; i0 = i1; i1 = i2; i2 = t_; } while (0)
  SLOAD(SE, 0); asm volatile("s_waitcnt vmcnt(0)" ::: "memory"); SWRITE(0, SE); __syncthreads();
  qkt(pA0, pA1, K_lds, qr, negm, r32, hi); partialSM(pA0, pA1, mhat, alA, negm, true);
  SLOAD(SO, KVBLK); if (2 < NT) SLOAD(SE, 2 * KVBLK);
  SWAIT(); SWRITE(1, SO); __syncthreads();
  for (int j = 1; j + 1 < NT; j += 2) {
    SBAR(); qkt(pB0, pB1, K_lds + i1 * SHM_K, qr, negm, r32, hi);
    finishSM(pA0, pA1, alA, l_reg, pa0, pa1, pa2, pa3); SBAR();
    SLOAD(SO, (j + 2) * KVBLK); SBAR();
    pv_d0(o, vb0 + i0 * SHM_V, pa0, pa1, pa2, pa3); partialSM(pB0, pB1, mhat, alB, negm, false);
    SWAIT(); SWRITE(i2, SE);
    RESC(alB); __syncthreads(); ROT3();
    SBAR(); qkt(pA0, pA1, K_lds + i1 * SHM_K, qr, negm, r32, hi);
    finishSM(pB0, pB1, alB, l_reg, pa0, pa1, pa2, pa3); SBAR();
    if (j + 3 < NT) SLOAD(SE, (j + 3) * KVBLK); SBAR();
    pv_d0(o, vb0 + i0 * SHM_V, pa0, pa1, pa2, pa3); partialSM(pA0, pA1, mhat, alA, negm, false);
    SWAIT(); SWRITE(i2, SO);
    RESC(alA); __syncthreads(); ROT3();
  }
  SBAR(); qkt(pB0, pB1, K_lds + i1 * SHM_K, qr, negm, r32, hi);
  finishSM(pA0, pA1, alA, l_reg, pa0, pa1, pa2, pa3); SBAR();
  pv_d0(o, vb0 + i0 * SHM_V, pa0, pa1, pa2, pa3); partialSM(pB0, pB1, mhat, alB, negm, false);
  RESC(alB);
  finishSM(pB0, pB1, alB, l_reg, pa0, pa1, pa2, pa3); SBAR();
  pv_d0(o, vb0 + i1 * SHM_V, pa0, pa1, pa2, pa3);
#undef ROT3
  if (hi == 0) li_l[r32] = l_reg; asm volatile("s_waitcnt lgkmcnt(0)" ::: "memory");
  float rli[16];
#pragma unroll
  for (int r = 0; r < 16; ++r) rli[r] = __builtin_amdgcn_rcpf(li_l[crow(r, hi)]);
  bf16_t* Ow = Ob + (long)(wid * QBLK) * DM;
#pragma unroll
  for (int r = 0; r < 16; ++r) { const int orow = crow(r, hi);
#pragma unroll
    for (int d0 = 0; d0 < 2; ++d0) Ow[(long)orow * DM + d0 * 32 + r32] = (bf16_t)f2bf(o[d0][r] * rli[r]); }
  __syncthreads();
#undef SLOAD
#undef SWRITE
#undef SWAIT
#undef RESC
}
#undef KSWZ
#undef SBAR
}

__device__ __forceinline__ void phase_attn(const Params& P, bool with_ctx, int vcu, int G, unsigned char* lds) {
    const bf16_t* Q = (const bf16_t*)(P.ws + WS_Q); const bf16_t* KV = (const bf16_t*)(P.ws + WS_KV); const bf16_t* KR = (const bf16_t*)(P.ws + WS_KROPE); bf16_t* mix = (bf16_t*)(P.ws + WS_H);
    const int nu = NBATCH * NHEAD * 8 + (with_ctx ? NBATCH * NHEAD : 0);
    for (int uid = vcu; uid < nu; uid += G) {
        int b, h, row0, seq, pos0;
        if (uid < NBATCH * NHEAD * 8) { const int bh = uid >> 3, qb = uid & 7; b = bh >> 3; h = bh & 7; row0 = b * TPB + CTXL + qb * 256; seq = TPB; pos0 = qb * 256; }
        else { const int bh = uid - NBATCH * NHEAD * 8; b = bh >> 3; h = bh & 7; row0 = b * TPB; seq = CTXL; pos0 = -1; }
        attn::attn_unit(Q + (size_t)row0 * QW + h * DQK, KV + (size_t)(b * TPB) * KVW + h * 128, KR + (size_t)(b * TPB) * DROPE, mix + (size_t)row0 * DM + h * DV, seq, (char*)lds, pos0, (const float*)(P.ws + WS_ROPE));
    }
}

#define LAS __attribute__((address_space(3)))
__device__ __forceinline__ void phase_gemm_in(const Params& P, int l, LAS unsigned char* lds, int bid, int nb, int skip = 0, int nsc = 0, int nss = 0) {
    pg8::Gemm g{(const bf16_t*)(P.ws + WS_H), wptr(P, l, WO_WIN), NR, INP, DM, DM}; pg8::StaticOrder S; S.init(NR, INP, nb, bid, skip, nsc, nss);
    EpiProj E{(bf16_t*)(P.ws + WS_PROJ), (const float*)(P.ws + WS_ROWSS) + (size_t)(l * 2 + 0) * NR, (const float*)(P.ws + WS_SHW) + (size_t)l * 17 * 7168};
    pg8::gemm_phase<EpiProj, pg8::StaticOrder, true, true>(lds, g, S, E);
}
__device__ __forceinline__ void phase_gemm_qkv(const Params& P, int l, LAS unsigned char* lds, int bid, int nb) {
    int K = 256; asm volatile("" : "+s"(K));
    pg8::Gemm g{(const bf16_t*)(P.ws + WS_PROJ) + C_QA, wptr(P, l, WO_WQB), NR, QW + KVW, K, INP, 3, C_KVA - C_QA}; pg8::StaticOrder S; S.init(NR, QW + KVW, nb, bid);
    EpiQKV E{(bf16_t*)(P.ws + WS_Q), (bf16_t*)(P.ws + WS_KV)};
    pg8::gemm_phase<EpiQKV, pg8::StaticOrder, true, true>(lds, g, S, E);
}
__device__ __forceinline__ void phase_gemm_out(const Params& P, int l, LAS unsigned char* lds, int bid, int nb, int skip) {
    pg8::Gemm g{(const bf16_t*)(P.ws + WS_H), wptr(P, l, WO_WOUT), NR, DM, DM, DM}; pg8::StaticOrder S; S.init(NR, DM, nb, bid, skip);
    EpiRes2 E{P.out, P.ws, l, 2, (const float*)(P.ws + WS_GS) + (size_t)((l * 2 + 1) * 17) * 1024, (bf16_t*)(P.ws + WS_H2), (float*)(P.ws + WS_ROWSS) + (size_t)(l * 2 + 1) * NR, l == 0 ? P.inp(0) : nullptr, l == 0 ? P.inp(2) : nullptr};
    pg8::gemm_phase<EpiRes2, pg8::StaticOrder, true, true>(lds, g, S, E);
}
__device__ __forceinline__ void phase_gemm_ffi(const Params& P, int l, LAS unsigned char* lds, int bid, int nb, int skip, int nsc = 0, int nss = 0) {
    pg8::Gemm g{(const bf16_t*)(P.ws + WS_H2), wptr(P, l, WO_WFI), NR, 2 * DFF, DM, DM}; pg8::StaticOrder S; S.init(NR, 2 * DFF, nb, bid, skip, nsc, nss);
    EpiSwiglu2 E{(bf16_t*)(P.ws + WS_ACT), (bf16_t*)(P.ws + WS_ACTC), (const float*)(P.ws + WS_ROWSS) + (size_t)(l * 2 + 1) * NR, (const float*)(P.ws + WS_SHW) + (size_t)l * 17 * 7168 + 1536};
    pg8::gemm_phase<EpiSwiglu2, pg8::StaticOrder, true, true>(lds, g, S, E);
}
__device__ __forceinline__ void phase_gemm_ffo(const Params& P, int l, LAS unsigned char* lds, int bid, int nb, int skip) {
    pg8::Gemm g{skip == 2 ? (const bf16_t*)(P.ws + WS_ACTC) : (const bf16_t*)(P.ws + WS_ACT), wptr(P, l, WO_WFO), NR, DM, DFF, DFF}; g.pm_div9 = (skip == 2);
    pg8::StaticOrder S; S.init(NR, DM, nb, bid, skip);
    const bool nxt = l + 1 < DEPTH;
    EpiRes2 E{P.out, P.ws, l, 5, nxt ? (const float*)(P.ws + WS_GS) + (size_t)(((l + 1) * 2 + 0) * 17) * 1024 : nullptr, (bf16_t*)(P.ws + WS_H), (float*)(P.ws + WS_ROWSS) + (size_t)((l + 1) * 2 + 0) * NR, nullptr, nullptr};
    pg8::gemm_phase<EpiRes2, pg8::StaticOrder, true, true>(lds, g, S, E);
}

__device__ __forceinline__ void phase_small_b(const Params& P, int l, int last, int bid, int nb, unsigned char* lds) {
    const int n_lru = NBATCH * 36, n_sgu = last ? NBATCH * 16 : NBATCH * 18, n_rs = NR / 128;
#pragma unroll 1
    for (int it = bid; it < n_lru + n_sgu + n_rs; it += nb) {
        if (it < n_lru) lru_item<1>(P, l, it / 36, it % 36, lds);
        else if (it < n_lru + n_sgu) { const int k = it - n_lru; if (last) sgu_item(P, l, k >> 4, 2 + (k & 15), lds); else sgu_item(P, l, k / 18, k % 18, lds); }
        else rowstat_item(P, it - n_lru - n_sgu);
    }
}
__device__ __forceinline__ void phase_lru2(const Params& P, int l, int last, int bid, int nb, unsigned char* lds) {
    const int n = last ? NBATCH * 32 : NBATCH * 36;
#pragma unroll 1
    for (int it = bid; it < n; it += nb) { if (last) lru_item<2>(P, l, it >> 5, 4 + (it & 31), lds); else lru_item<2>(P, l, it / 36, it % 36, lds); }
}

#define XB_TMO      128
#define XB_XCNT(j)  (256  + 64 * (j))
#define XB_XSUB(j)  (1280 + 64 * (j))
#define XB_XGEN(j)  (2304 + 64 * (j))
#define XB_TOP      3328
#define XB_TOPGEN   3392
#define XCD_BAR_WORDS 3456
#define XB_SPIN_CAP (1u << 22)
constexpr int CW_BAR = 4096;
__device__ __forceinline__ unsigned xb_ld(unsigned* p)              { return __hip_atomic_load(p, __ATOMIC_RELAXED, __HIP_MEMORY_SCOPE_AGENT); }
__device__ __forceinline__ unsigned xb_add(unsigned* p, unsigned v) { return __hip_atomic_fetch_add(p, v, __ATOMIC_RELAXED, __HIP_MEMORY_SCOPE_AGENT); }
__device__ __forceinline__ unsigned xb_xcc_id() { return (unsigned)__builtin_amdgcn_s_getreg((3 << 11) | 20) & 0xFu; }
#define XB_SPIN(cond, bar) do { unsigned _sp = 0; while (cond) { __builtin_amdgcn_s_sleep(1); \
    if ((++_sp & 255u) == 0u) { if (xb_ld(&(bar)[XB_TMO])) break; if (_sp > XB_SPIN_CAP) { atomicAdd(&(bar)[XB_TMO], 1u); break; } } } } while (0)
struct XcdBarrier { unsigned* bar; unsigned x; volatile LAS unsigned* st; };
__device__ __forceinline__ XcdBarrier xcd_barrier_post(unsigned* bar, volatile LAS unsigned* st) {
    XcdBarrier b; b.bar = bar; b.x = xb_xcc_id(); b.st = st;
    if (threadIdx.x == 0) (void)xb_add(&bar[XB_XCNT(b.x)], 1u);
    return b;
}
__device__ __forceinline__ void xcd_barrier_complete(unsigned* bar, unsigned x, unsigned& nloc, unsigned& nx) {
    const unsigned G = gridDim.x * gridDim.y * gridDim.z;
    unsigned sum, cnt, mine, sp = 0u;
    for (;;) {
        sum = 0u; cnt = 0u; mine = 0u;
#pragma unroll
        for (unsigned j = 0; j < 16; ++j) { const unsigned c = xb_ld(&bar[XB_XCNT(j)]); sum += c; cnt += (c > 0u) ? 1u : 0u; mine = (j == x) ? c : mine; }
        if (sum == G) break;
        __builtin_amdgcn_s_sleep(1);
        if ((++sp & 255u) == 0u) { if (xb_ld(&bar[XB_TMO])) break; if (sp > XB_SPIN_CAP) { atomicAdd(&bar[XB_TMO], 1u); break; } }
    }
    nloc = mine > 0u ? mine : 1u; nx = cnt > 0u ? cnt : 1u;
}
__device__ __forceinline__ void xcd_barrier(const XcdBarrier& b) {
    asm volatile("s_waitcnt vmcnt(0)" ::: "memory");
    __syncthreads();
    if (threadIdx.x == 0) {
        unsigned* bar = b.bar; const unsigned bx_ = xb_xcc_id();
        __builtin_amdgcn_s_waitcnt(0);
        unsigned nloc = b.st[0], nx = b.st[1];
        if (nloc == 0u) { xcd_barrier_complete(bar, bx_, nloc, nx); b.st[0] = nloc; b.st[1] = nx; }
        const unsigned old = xb_add(&bar[XB_XSUB(bx_)], 1u);
        const unsigned gen = old / nloc;
        if (old + 1u == (gen + 1u) * nloc) {
            __builtin_amdgcn_fence(__ATOMIC_RELEASE, "agent");
            asm volatile("s_waitcnt vmcnt(0)" ::: "memory");
            const unsigned og = xb_add(&bar[XB_TOP], 1u);
            const unsigned tg = og / nx;
            if (og + 1u == (tg + 1u) * nx) xb_add(&bar[XB_TOPGEN], 1u);
            else XB_SPIN(xb_ld(&bar[XB_TOPGEN]) == tg, bar);
            __builtin_amdgcn_fence(__ATOMIC_ACQUIRE, "agent");
            xb_add(&bar[XB_XGEN(bx_)], 1u);
            asm volatile("s_waitcnt vmcnt(0)" ::: "memory");
        } else {
            XB_SPIN(xb_ld(&bar[XB_XGEN(bx_)]) == gen, bar);
            __builtin_amdgcn_fence(__ATOMIC_ACQUIRE, "agent");
            asm volatile("s_waitcnt vmcnt(0)" ::: "memory");
        }
    }
    __syncthreads();
}

constexpr int MISC_OFF = 131072 + 320, INTAB_OFF = 131072 + 2048;
__global__ void __launch_bounds__(NTHR, 2) mega_fwd(KArgs A) {
    extern __shared__ __attribute__((aligned(16))) unsigned char lds[];
    LAS unsigned char* lds3 = (LAS unsigned char*)lds;
    int bid = blockIdx.x, nb = gridDim.x;
    int vcu = (nb % 8 == 0) ? (bid % 8) * (nb / 8) + bid / 8 : bid;
    for (int u = threadIdx.x; u < (LDS_BYTES - 131072) / 4; u += NTHR) ((LAS unsigned*)(lds3 + 131072))[u] = 0u;
    __syncthreads();
    if (threadIdx.x < 28) ((LAS unsigned long long*)(lds3 + INTAB_OFF))[threadIdx.x] = (unsigned long long)A.in[threadIdx.x];
    __syncthreads();
    Params P; P.intab = (unsigned)(uintptr_t)(lds3 + INTAB_OFF); P.out = (GAS1 float*)A.out; P.ws = (GAS1 unsigned char*)A.ws;
    const XcdBarrier bar = xcd_barrier_post((unsigned*)(P.ws + WS_CTL) + CW_BAR, (volatile LAS unsigned*)(lds3 + MISC_OFF) + 8);
#define GBAR() xcd_barrier(bar)
    Params Q = P;
#define LND() asm volatile("" : "+s"(Q.ws), "+s"(Q.out), "+s"(bid), "+s"(nb), "+s"(vcu))
    LND(); stage_wprep(Q, bid, nb, lds);
    LND(); stage_mod(Q, bid, nb, lds);
    GBAR();
    LND(); stage_tables(Q, bid, nb, lds); LND(); stage_entry(Q, bid, nb);
    GBAR();
    LND(); phase_gemm_in(Q, 0, lds3, bid, nb);
    GBAR();
#pragma unroll 1
    for (int l = 0; l < DEPTH; ++l) {
        const int last = (l == DEPTH - 1) ? 1 : 0;
        LND(); phase_small_b(Q, l, last, bid, nb, lds);
        GBAR();
        LND(); phase_gemm_qkv(Q, l, lds3, bid, nb); LND(); phase_lru2(Q, l, last, bid, nb, lds);
        GBAR();
        LND(); phase_attn(Q, !last, vcu, nb, lds);
        GBAR();
        LND(); stage_finalize(Q, bid, nb, last);
        GBAR();
        if (last) {
            LND(); phase_gemm_out(Q, l, lds3, bid, nb, 1);
            GBAR();
            LND(); phase_gemm_ffi(Q, l, lds3, bid, nb, 1);
            GBAR();
            LND(); phase_gemm_ffo(Q, l, lds3, bid, nb, 1);
            GBAR();
        } else {
            LND(); phase_gemm_out(Q, l, lds3, bid, nb, 1);
            GBAR();
            LND(); phase_gemm_out(Q, l, lds3, bid, nb, 2); LND(); phase_gemm_ffi(Q, l, lds3, bid, nb, 1, 64, 2);
            GBAR();
            LND(); phase_gemm_ffi(Q, l, lds3, bid, nb, 2); LND(); phase_gemm_ffo(Q, l, lds3, bid, nb, 1);
            GBAR();
            LND(); phase_gemm_ffo(Q, l, lds3, bid, nb, 2); LND(); phase_gemm_in(Q, l + 1, lds3, bid, nb, 1, 64, 3);
            GBAR();
            LND(); phase_gemm_in(Q, l + 1, lds3, bid, nb, 2);
            GBAR();
        }
    }
    LND(); stage_norm(Q, 0, 3, bid, nb);

#undef LND
#undef GBAR
}

extern "C" void kernel_launch(void* const* d_in, const int* in_sizes, int n_in, void* d_out, int out_size, void* d_ws, size_t ws_size, hipStream_t stream) {
    static int ok = 0; static int mega_grid = 0;
    if (ok == 0) {
        if (n_in != 28 || out_size != NBATCH * SEQ * DM || ws_size < WS_END) { fprintf(stderr, "kernel_launch: unexpected shapes n_in %d out %d ws %zu\n", n_in, out_size, ws_size); ok = -1; return; }
        if (hipFuncSetAttribute((const void*)mega_fwd, hipFuncAttributeMaxDynamicSharedMemorySize, LDS_BYTES) != hipSuccess) { fprintf(stderr, "hipFuncSetAttribute(mega) failed\n"); ok = -1; return; }
        int dev = 0, cus = 0, per_cu = 0;
        (void)hipGetDevice(&dev); (void)hipDeviceGetAttribute(&cus, hipDeviceAttributeMultiprocessorCount, dev);
        if (hipOccupancyMaxActiveBlocksPerMultiprocessor(&per_cu, (const void*)mega_fwd, NTHR, LDS_BYTES) != hipSuccess || per_cu < 1) { fprintf(stderr, "occupancy query: %d blocks per CU\n", per_cu); ok = -1; return; }
        (void)hipGetLastError();
        mega_grid = cus;
        ok = 1;
    }
    if (ok < 0) return;
    KArgs P{};
    for (int i = 0; i < 28; ++i) P.in[i] = (const float*)d_in[i];
    P.out = (float*)d_out; P.ws = (unsigned char*)d_ws;
    (void)hipMemsetAsync((char*)d_ws + WS_CTL, 0, CTL_BYTES, stream);
    { void* args[] = {(void*)&P};
      hipError_t e = hipLaunchCooperativeKernel((const void*)mega_fwd, dim3(mega_grid), dim3(NTHR), args, LDS_BYTES, stream);
      if (e != hipSuccess) fprintf(stderr, "cooperative launch failed: %s (grid %d)\n", hipGetErrorString(e), mega_grid); }
}
```

```cpp
#include <hip/hip_runtime.h>
#include <stdint.h>
#include <stdio.h>

constexpr int DM = 1024, NBATCH = 16, SEQ = 2048, CTXL = 256, TPB = SEQ + CTXL  , NR = NBATCH * TPB  ;
constexpr int DEPTH = 2, GRIDW = 64;
constexpr int NHEAD = 8, DNOPE = 64, DROPE = 32, DQK = 96, DV = 64, QLORA = 256, KVLORA = 128;
constexpr int LRUW = 256, SGUW = 256, CHUNK = 128;
constexpr int INW = 1440, INP = 1536;
constexpr int C_QA = 0, C_KVA = 256, C_KR = 384, C_XR = 416, C_GR = 672, C_SU = 928, C_SV = 1184;
constexpr int DFF = 2816;
constexpr int QW = NHEAD * DQK  , KVW = NHEAD * (DNOPE + DV)  ;
constexpr float EPS = 1e-6f;
constexpr int NTHR = 512;
constexpr int LDS_BYTES = 147456;

constexpr size_t MiB = 1u << 20;
constexpr size_t WS_CTL = 0, CTL_BYTES = 2 * MiB;
constexpr size_t WS_MOD = 128 * 1024;
constexpr size_t WS_SMALL = 2 * MiB;
constexpr size_t WS_ROPE = WS_SMALL;
constexpr size_t WS_RQA = WS_SMALL + 64 * 1024;
constexpr size_t WS_LRUC = WS_SMALL + 16 * 1024;
constexpr size_t WS_RKVA = WS_RQA + NR * 4;
constexpr size_t WS_GS = WS_RKVA + NR * 4;
constexpr size_t WS_SHW = 3 * MiB;
static_assert(WS_GS + 2 * 2 * 17 * 1024 * 4 <= WS_SHW && WS_SHW + 2 * 17 * 7168 * 4 <= 4 * MiB, "small region");
constexpr size_t WS_ROWSS = 1 * MiB;
constexpr size_t WS_AGG = 449 * MiB;
constexpr size_t WS_W = 4 * MiB;
constexpr size_t WSZ_WIN = (size_t)INP * DM * 2, WSZ_WQB = (size_t)QW * 256 * 2, WSZ_WKVB = (size_t)KVW * 256 * 2, WSZ_WOUT = (size_t)DM * DM * 2,
                 WSZ_WFI = (size_t)2 * DFF * DM * 2, WSZ_WFO = (size_t)DM * DFF * 2;
constexpr size_t WO_WIN = 0, WO_WQB = WO_WIN + WSZ_WIN, WO_WKVB = WO_WQB + WSZ_WQB, WO_WOUT = WO_WKVB + WSZ_WKVB, WO_WFI = WO_WOUT + WSZ_WOUT, WO_WFO = WO_WFI + WSZ_WFI,
                 WSZ_LAYER = WO_WFO + WSZ_WFO;
static_assert(WS_W + 2 * WSZ_LAYER <= 49 * MiB, "weights");
constexpr size_t WS_WLRU = 49 * MiB;
constexpr size_t WS_WSGU = 50 * MiB;
constexpr size_t WS_CRES = 52 * MiB;
constexpr size_t WS_H = 68 * MiB;
constexpr size_t WS_PROJ = 140 * MiB;
constexpr size_t WS_Q = 248 * MiB;
constexpr size_t WS_KV = 302 * MiB;
constexpr size_t WS_KROPE = 374 * MiB;
constexpr size_t WS_H2 = 377 * MiB;
constexpr size_t WS_ACT = 140 * MiB;
constexpr size_t WS_ACTC = 452 * MiB;
constexpr size_t WS_END = 475 * MiB;
static_assert(WS_ACT + (size_t)NR * DFF * 2 <= WS_KROPE, "act overlay");
static_assert(WS_H2 + (size_t)NR * DM * 2 <= WS_AGG && WS_ROWSS + 4 * NR * 4 <= CTL_BYTES && WS_AGG + 3 * MiB <= WS_ACTC && WS_ACTC + (size_t)NBATCH * CTXL * DFF * 2 <= WS_END, "map");

typedef unsigned short bf16_t;
typedef float f32x4 __attribute__((ext_vector_type(4)));
typedef unsigned u32x4 __attribute__((ext_vector_type(4)));
typedef unsigned u32x2 __attribute__((ext_vector_type(2)));
typedef short bf16x8_t __attribute__((ext_vector_type(8)));

struct KArgs {
    const float* in[28];
    float* out;
    unsigned char* ws;
};
#define GAS1 __attribute__((address_space(1)))
struct Params {
    unsigned intab;
    GAS1 float* out;
    GAS1 unsigned char* ws;
    __device__ __forceinline__ const float* inp(int i) const {
        const unsigned long long v = *(const __attribute__((address_space(3))) unsigned long long*)(intab + 8u * (unsigned)i);
        const unsigned lo = __builtin_amdgcn_readfirstlane((unsigned)v), hi = __builtin_amdgcn_readfirstlane((unsigned)(v >> 32));
        return (const float*)(const __attribute__((address_space(1))) float*)(((unsigned long long)hi << 32) | lo);
    }
};

__device__ __forceinline__ int opaque_tid() { int t = threadIdx.x; asm volatile("" : "+v"(t)); return t; }
#define TIDX opaque_tid()
#define LOADS_ISSUED() asm volatile("" ::: "memory")
__device__ __forceinline__ unsigned f2bf(float f) { unsigned u = __builtin_bit_cast(unsigned, f); return (u + 0x7fffu + ((u >> 16) & 1u)) >> 16; }
__device__ __forceinline__ float bf2f(unsigned h) { return __builtin_bit_cast(float, (h & 0xffffu) << 16); }
__device__ __forceinline__ unsigned pk2(float lo, float hi) { return f2bf(lo) | (f2bf(hi) << 16); }
__device__ __forceinline__ float bflo(unsigned w) { return __builtin_bit_cast(float, w << 16); }
__device__ __forceinline__ float bfhi(unsigned w) { return __builtin_bit_cast(float, w & 0xffff0000u); }
#define DPP_ADD(v, ctrl) ((v) + __builtin_bit_cast(float, __builtin_amdgcn_update_dpp(0, __builtin_bit_cast(int, (v)), (ctrl), 0xF, 0xF, true)))
__device__ __forceinline__ float wave_sum(float v) {
    v = DPP_ADD(v, 0xB1); v = DPP_ADD(v, 0x4E); v = DPP_ADD(v, 0x141); v = DPP_ADD(v, 0x140);
    const int iv = __builtin_bit_cast(int, v);
    const float r0 = __builtin_bit_cast(float, __builtin_amdgcn_readlane(iv, 0)), r1 = __builtin_bit_cast(float, __builtin_amdgcn_readlane(iv, 16)),
                r2 = __builtin_bit_cast(float, __builtin_amdgcn_readlane(iv, 32)), r3 = __builtin_bit_cast(float, __builtin_amdgcn_readlane(iv, 48));
    return (r0 + r1) + (r2 + r3);
}
__device__ __forceinline__ float fexp_(float x) { return __builtin_amdgcn_exp2f(1.4426950408889634f * x); }
__device__ __forceinline__ float sigmoidf_(float x) { return __builtin_amdgcn_rcpf(1.f + __builtin_amdgcn_exp2f(-1.4426950408889634f * x)); }
__device__ __forceinline__ float siluf_(float x) { return x * __builtin_amdgcn_rcpf(1.f + __builtin_amdgcn_exp2f(-1.4426950408889634f * x)); }
__device__ __forceinline__ float geluf_(float x) {
    const float u2 = 1.5957691216057308f * (x + 0.044715f * x * x * x);
    return x * __builtin_amdgcn_rcpf(1.f + __builtin_amdgcn_exp2f(-1.4426950408889634f * u2));
}
__device__ __forceinline__ float* res_row(const Params& P, int r) {
    const int b = r / TPB, t = r - b * TPB;
    return t < CTXL ? (float*)(P.ws + WS_CRES) + ((size_t)(b * CTXL + t)) * DM : (float*)(P.out + ((size_t)(b * SEQ + (t - CTXL))) * DM);
}
__device__ __forceinline__ const float* modp(const Params& P, int l, int r, int chunk) {
    const int b = r / TPB, t = r - b * TPB; const int mr = t < CTXL ? 16 : b;
    return (const float*)(P.ws + WS_MOD) + ((size_t)(l * 17 + mr)) * 6144 + chunk * 1024;
}
__device__ __forceinline__ bf16_t* wptr(const Params& P, int l, size_t off) { return (bf16_t*)(P.ws + WS_W + (size_t)l * WSZ_LAYER + off); }

struct WItem { const float* W; int K, N; bf16_t* Wt; int KP, kind; const float* gain; int kt, nt4, nsub; };
__device__ __forceinline__ WItem wprep_decode(const Params& P, int it) {
    constexpr int I0 = 16 * 6, I1 = 4 * 3, I2 = 4 * 4, I3 = 16 * 4, I4 = 16 * 22, I5 = 44 * 4, IL = I0 + I1 + I2 + I3 + I4 + I5;
    if (it >= 2 * IL) {
        const int q = it - 2 * IL; const int l = q >> 4, d = (q >> 3) & 1, gate = (q >> 2) & 1, hh = q & 3;
        return WItem{(gate ? P.inp(17) : P.inp(15)) + ((size_t)((l * 2 + d) * 4 + hh)) * 4096, 64, 64, (bf16_t*)(P.ws + WS_WLRU) + ((size_t)(((l * 2 + d) * 2 + gate) * 4 + hh)) * 4096, 64, 6, nullptr, 0, 0, 1}; }
    const int l = it / IL; int r = it % IL;
    if (r < I0) return WItem{P.inp(8) + (size_t)l * DM * INW, DM, INW, wptr(P, l, WO_WIN), DM, 0, nullptr, r % 16, r / 16, 4}; r -= I0;
    if (r < I1) return WItem{P.inp(10) + (size_t)l * QLORA * QW, QLORA, QW, wptr(P, l, WO_WQB), 256, 1, P.inp(9) + l * QLORA, r % 4, r / 4, 4}; r -= I1;
    if (r < I2) return WItem{P.inp(12) + (size_t)l * KVLORA * KVW, KVLORA, KVW, wptr(P, l, WO_WKVB), 256, 2, P.inp(11) + l * KVLORA, r % 4, r / 4, 4}; r -= I2;
    if (r < I3) return WItem{P.inp(24) + (size_t)l * DM * DM, DM, DM, wptr(P, l, WO_WOUT), DM, 3, P.inp(23) + l * DM, r % 16, r / 16, 4}; r -= I3;
    if (r < I4) return WItem{P.inp(25) + (size_t)l * DM * 2 * DFF, DM, 2 * DFF, wptr(P, l, WO_WFI), DM, 4, nullptr, r % 16, r / 16, 4}; r -= I4;
    return WItem{P.inp(26) + (size_t)l * DFF * DM, DFF, DM, wptr(P, l, WO_WFO), DFF, 5, nullptr, r % 44, r / 44, 4};
}
__device__ __forceinline__ int wprep_src(const WItem& w, int e, int& k, int& sub, int& n4, bool& ok) {
    sub = e / 1024; const int r = e % 1024; k = r >> 4; n4 = r & 15; const int nn = w.nt4 * 256 + sub * 64, k0 = w.kt * 64;
    int s0; if (w.kind == 4) { const int pn = nn / 256, half = (nn % 256) / 128, jj = nn % 128; s0 = half * DFF + pn * 128 + jj; } else s0 = nn;
    ok = (k0 + k < w.K) && (s0 + n4 * 4 < w.N);
    const int kk = (k0 + k < w.K) ? k0 + k : w.K - 1, cc = (s0 + n4 * 4 < w.N) ? s0 + n4 * 4 : 0;
    return kk * w.N + cc;
}
__device__ __forceinline__ void wprep_load(const WItem& w, int tid, f32x4 (&lv)[8]) {
#pragma unroll
    for (int q = 0; q < 8; ++q) { const int e = tid + q * NTHR; lv[q] = (f32x4){0.f, 0.f, 0.f, 0.f};
        if (e < 64 * 16 * w.nsub) { int k, sub, n4; bool ok; const int off = wprep_src(w, e, k, sub, n4, ok); lv[q] = *(const f32x4*)(w.W + off); } }
}
__device__ __forceinline__ void wprep_store(const WItem& w, int tid, const f32x4 (&lv)[8], float* t  ) {
    __syncthreads();
#pragma unroll
    for (int q = 0; q < 8; ++q) { const int e = tid + q * NTHR;
        if (e < 64 * 16 * w.nsub) { int k, sub, n4; bool ok; (void)wprep_src(w, e, k, sub, n4, ok); f32x4 v = lv[q];
            if (w.gain) v = v * w.gain[(w.kt * 64 + k < w.K) ? w.kt * 64 + k : w.K - 1];
            if (!ok) v = (f32x4){0.f, 0.f, 0.f, 0.f};
            float* tp = t + k * 260 + sub * 65 + n4 * 4; tp[0] = v.x; tp[1] = v.y; tp[2] = v.z; tp[3] = v.w; } }
    __syncthreads();
    for (int e = tid; e < 64 * 8 * w.nsub; e += NTHR) { const int n = e >> 3, k8 = e & 7, sub = n >> 6, nl = n & 63; const float* tp = t + (k8 * 8) * 260 + sub * 65 + nl;
        u32x4 o; o.x = pk2(tp[0], tp[260]); o.y = pk2(tp[2 * 260], tp[3 * 260]); o.z = pk2(tp[4 * 260], tp[5 * 260]); o.w = pk2(tp[6 * 260], tp[7 * 260]);
        *(u32x4*)(w.Wt + (size_t)(w.nt4 * 256 + n) * w.KP + w.kt * 64 + k8 * 8) = o; }
}
__device__ __forceinline__ void stage_wprep(const Params& P, int bid, int nb, unsigned char* lds) {
    float* t = (float*)lds; const int tid = TIDX;
    constexpr int NIT = 2 * (16 * 6 + 4 * 3 + 4 * 4 + 16 * 4 + 16 * 22 + 44 * 4) + 32;
    f32x4 la[8], lb[8];
    int it = bid;
    if (it < NIT) { const WItem w = wprep_decode(P, it); wprep_load(w, tid, la); }
#pragma unroll 1
    for (; it < NIT; it += 2 * nb) {
        const WItem wa = wprep_decode(P, it);
        const bool hasb = it + nb < NIT;
        if (hasb) { const WItem wb = wprep_decode(P, it + nb); wprep_load(wb, tid, lb); }
        LOADS_ISSUED();
        wprep_store(wa, tid, la, t);
        if (!hasb) break;
        if (it + 2 * nb < NIT) { const WItem wn = wprep_decode(P, it + 2 * nb); wprep_load(wn, tid, la); }
        LOADS_ISSUED();
        { const WItem wb = wprep_decode(P, it + nb); wprep_store(wb, tid, lb, t); }
    }
    { bf16_t* Wd = (bf16_t*)(P.ws + WS_WSGU); const float* Wsrc = P.inp(21);
      for (int e = (bid * NTHR + tid) * 4; e < 2 * 4 * 16384; e += nb * NTHR * 4) { const f32x4 v = *(const f32x4*)(Wsrc + e); u32x2 w; w.x = pk2(v.x, v.y); w.y = pk2(v.z, v.w); *(u32x2*)(Wd + e) = w; } }
}

__device__ __forceinline__ void stage_mod(const Params& P, int bid, int nb, unsigned char* lds, size_t dst_off = WS_MOD) {
    const int tid = TIDX;
    if (bid == 0) {
        float* tab = (float*)(P.ws + WS_ROPE); const int p = tid >> 3, j = tid & 7;
        const float f = powf(10000.0f, -(float)j / 8.0f); const float a = (float)p * f;
        tab[tid] = cosf(a); tab[512 + tid] = sinf(a);
    }
    float* s = (float*)lds;
    float* red = s + 17 * 128;
    float* mod = (float*)(P.ws + dst_off);
    for (int it = bid; it < 2 * 96 * 8; it += nb) {
        const int l = it / 768, r = it % 768, cg = r / 8, kc = r % 8, n0 = cg * 64, k0 = kc * 128;
        __syncthreads();
        const int col = tid & 63, ks = tid >> 6;
        const float* w = P.inp(6) + ((size_t)l * DM + k0 + ks * 16) * 6144 + n0 + col;
        float wv[16], cv5[5];
        { const float* cp = P.inp(1); const float* cx = P.inp(3);
#pragma unroll
          for (int q = 0; q < 5; ++q) { const int e = tid + q * NTHR; const int ee = e < 17 * 128 ? e : 0; const int i = ee >> 7, k = ee & 127; const float* src = i < 16 ? cp + i * DM + k0 + k : cx + k0 + k; cv5[q] = *src; }
#pragma unroll
          for (int kk = 0; kk < 16; ++kk) wv[kk] = w[(size_t)kk * 6144]; }
        LOADS_ISSUED();
#pragma unroll
        for (int q = 0; q < 5; ++q) { const int e = tid + q * NTHR; if (e < 17 * 128) s[e] = siluf_(cv5[q]); }
        __syncthreads();
        float acc[17];
#pragma unroll
        for (int i = 0; i < 17; ++i) acc[i] = 0.f;
#pragma unroll
        for (int kk = 0; kk < 16; ++kk) {
#pragma unroll
            for (int i = 0; i < 17; ++i) acc[i] += s[i * 128 + ks * 16 + kk] * wv[kk]; }
#pragma unroll
        for (int i = 0; i < 17; ++i) red[(ks * 17 + i) * 64 + col] = acc[i];
        __syncthreads();
        for (int e = tid; e < 17 * 64; e += NTHR) { const int i = e >> 6, c = e & 63; float v = 0.f;
#pragma unroll
            for (int q = 0; q < 8; ++q) v += red[(q * 17 + i) * 64 + c];
            if (kc == 0) v += P.inp(7)[l * 6144 + n0 + c];
            atomicAdd(mod + ((size_t)(l * 17 + i)) * 6144 + n0 + c, v); }
    }
}

__device__ __forceinline__ void stage_tables(const Params& P, int bid, int nb, unsigned char* lds) {
    const int tid = TIDX, lane = tid & 63, w = tid >> 6, fr = lane & 15, fq = lane >> 4;
    const float* mod = (const float*)(P.ws + WS_MOD);
    constexpr int SH_P = 1032;
    bf16_t* sh = (bf16_t*)lds;
    for (int it = bid; it < 112; it += nb) {
        const int l = it / 56, ch = it % 56, which = ch < 12 ? 0 : 1; const int n0 = ch * 128 + w * 16;
        __syncthreads();
        for (int e = tid; e < 32 * 1024; e += NTHR) { const int i = e >> 10, k = e & 1023; sh[i * SH_P + k] = i < 17 ? (bf16_t)f2bf(mod[((size_t)(l * 17 + i)) * 6144 + (which ? 3 : 0) * 1024 + k]) : (bf16_t)0; }
        __syncthreads();
        const bf16_t* wrow = (which ? wptr(P, l, WO_WFI) + (size_t)(n0 - 1536 + fr) * DM : wptr(P, l, WO_WIN) + (size_t)(n0 + fr) * DM) + fq * 8;
        f32x4 a0 = (f32x4){0.f, 0.f, 0.f, 0.f}, a1 = (f32x4){0.f, 0.f, 0.f, 0.f};
#pragma unroll 4
        for (int ks = 0; ks < 32; ++ks) { const bf16x8_t B = *(const bf16x8_t*)(wrow + ks * 32);
            const bf16x8_t A0 = *(const bf16x8_t*)(sh + fr * SH_P + ks * 32 + fq * 8), A1 = *(const bf16x8_t*)(sh + (16 + fr) * SH_P + ks * 32 + fq * 8);
            a0 = __builtin_amdgcn_mfma_f32_16x16x32_bf16(A0, B, a0, 0, 0, 0); a1 = __builtin_amdgcn_mfma_f32_16x16x32_bf16(A1, B, a1, 0, 0, 0); }
        float* shw = (float*)(P.ws + WS_SHW) + (size_t)(l * 17) * 7168 + n0 + fr;
#pragma unroll
        for (int reg = 0; reg < 4; ++reg) shw[(size_t)(fq * 4 + reg) * 7168] = a0[reg];
        if (fq == 0) shw[(size_t)16 * 7168] = a1[0];
    }
    if (bid == nb - 1) { f32x4* lc = (f32x4*)(P.ws + WS_LRUC);
        for (int e = tid; e < 2 * 2 * 256; e += NTHR) { const float lam = P.inp(19)[e]; lc[e] = (f32x4){P.inp(16)[e], P.inp(18)[e], -8.f * ((lam > 15.f) ? __expf(-lam) : log1pf(__expf(-lam))), 0.f}; } }
    float* gs = (float*)(P.ws + WS_GS);
    for (int e = bid * NTHR + tid; e < 2 * 2 * 17 * 1024; e += nb * NTHR) { const int k = e & 1023, i = (e >> 10) % 17, wq = ((e >> 10) / 17) & 1, l = (e >> 10) / 34;
        gs[e] = (wq ? P.inp(5) : P.inp(4))[l * DM + k] * (1.f + mod[((size_t)(l * 17 + i)) * 6144 + (wq ? 4 : 1) * 1024 + k]); }
}
__device__ __forceinline__ void stage_entry(const Params& P, int cls  , int i_lo, int i_hi, int bid, int nb) {
    const int lane = TIDX & 63, gw = bid * (NTHR / 64) + (TIDX >> 6), ngw = nb * (NTHR / 64);
    bf16_t* H = (bf16_t*)(P.ws + WS_H); float* rowss = (float*)(P.ws + WS_ROWSS);
    for (int ix = i_lo + gw; ix < i_hi; ix += ngw) {
        const int r = cls ? (ix >> 11) * TPB + CTXL + (ix & 2047) : (ix >> 8) * TPB + (ix & 255);
        const int b = r / TPB, t = r - b * TPB; const bool isctx = t < CTXL;
        const float* src = isctx ? P.inp(2) + ((size_t)(b * CTXL + t)) * DM : P.inp(0) + ((size_t)(b * SEQ + t - CTXL)) * DM;
        f32x4 v[4], gv[4], scv[4]; float ss = 0.f;
        const float* g = P.inp(4); const float* sc = modp(P, 0, r, 1);
#pragma unroll
        for (int j = 0; j < 4; ++j) { const int c = j * 256 + lane * 4; v[j] = *(const f32x4*)(src + c); gv[j] = *(const f32x4*)(g + c); scv[j] = *(const f32x4*)(sc + c); }
        LOADS_ISSUED();
#pragma unroll
        for (int j = 0; j < 4; ++j) ss += v[j].x * v[j].x + v[j].y * v[j].y + v[j].z * v[j].z + v[j].w * v[j].w;
        ss = wave_sum(ss);
        if (lane == 0) rowss[r] = ss;
#pragma unroll
        for (int j = 0; j < 4; ++j) { const int c = j * 256 + lane * 4;
            const f32x4 y = v[j] * gv[j] * (1.f + scv[j]);
            u32x2 w; w.x = pk2(y.x, y.y); w.y = pk2(y.z, y.w);
            *(u32x2*)(H + (size_t)r * DM + c) = w; }
    }
}

__device__ __forceinline__ void stage_norm(const Params& P, int l, int mode, int bid, int nb, int skipctx = 0) {
    const int lane = TIDX & 63, gw = bid * (NTHR / 64) + (TIDX >> 6), ngw = nb * (NTHR / 64);
    bf16_t* H = (bf16_t*)(P.ws + WS_H);
    for (int r = gw; r < NR; r += ngw) {
        const int b = r / TPB, t = r - b * TPB; const bool isctx = t < CTXL;
        if ((mode == 3 || skipctx) && isctx) continue;
        float* res = res_row(P, r);
        const float* src = res;
        if (mode == 0) src = isctx ? P.inp(2) + ((size_t)(b * CTXL + t)) * DM : P.inp(0) + ((size_t)(b * SEQ + t - CTXL)) * DM;
        f32x4 v[4]; float ss = 0.f;
#pragma unroll
        for (int j = 0; j < 4; ++j) { v[j] = *(const f32x4*)(src + j * 256 + lane * 4); ss += v[j].x * v[j].x + v[j].y * v[j].y + v[j].z * v[j].z + v[j].w * v[j].w; }
        ss = wave_sum(ss);
        const float rs = rsqrtf(ss * (1.f / DM) + EPS);
        if (mode == 0) {
#pragma unroll
            for (int j = 0; j < 4; ++j) *(f32x4*)(res + j * 256 + lane * 4) = v[j];
        }
        if (mode == 3) {
            const float* g = P.inp(27); f32x4 gv[4];
#pragma unroll
            for (int j = 0; j < 4; ++j) gv[j] = *(const f32x4*)(g + j * 256 + lane * 4);
            LOADS_ISSUED();
#pragma unroll
            for (int j = 0; j < 4; ++j) { f32x4 o = v[j] * rs * gv[j]; *(f32x4*)(res + j * 256 + lane * 4) = o; }
            continue;
        }
        const float* g = (mode == 1 ? P.inp(5) : P.inp(4)) + l * DM;
        const float* sh = modp(P, l, r, mode == 1 ? 3 : 0);
        const float* sc = modp(P, l, r, mode == 1 ? 4 : 1);
#pragma unroll
        for (int j = 0; j < 4; ++j) { const int c = j * 256 + lane * 4;
            const f32x4 gv = *(const f32x4*)(g + c), shv = *(const f32x4*)(sh + c), scv = *(const f32x4*)(sc + c);
            const f32x4 y = (v[j] * rs * gv) * (1.f + scv) + shv;
            u32x2 w; w.x = pk2(y.x, y.y); w.y = pk2(y.z, y.w);
            *(u32x2*)(H + (size_t)r * DM + c) = w; }
    }
}

__device__ __forceinline__ float rope_one(const float* tab, float x, float partner, int i, int prow, int pcol) {
    const int p = (i < 16) ? prow : pcol; const float c = tab[p * 8 + (i & 7)], s = tab[512 + p * 8 + (i & 7)];
    const float rot = (i & 8) ? partner : -partner;
    return x * c + rot * s;
}
__device__ __forceinline__ void rowstat_item(const Params& P, int item) {
    const int lane = TIDX & 63, w = TIDX >> 6;
    bf16_t* proj = (bf16_t*)(P.ws + WS_PROJ); const float* tab = (const float*)(P.ws + WS_ROPE); bf16_t* krope = (bf16_t*)(P.ws + WS_KROPE);
    { const int rb = item * 128 + w * 16;
        u32x2 a[16]; unsigned k[16]; unsigned short xr[16];
#pragma unroll
        for (int i = 0; i < 16; ++i) { const bf16_t* pr = proj + (size_t)(rb + i) * INP; a[i] = *(const u32x2*)(pr + C_QA + lane * 4); k[i] = *(const unsigned*)(pr + C_KVA + lane * 2); xr[i] = pr[C_KR + (lane & 31)]; }
        float rc[16], rsn[16];
#pragma unroll
        for (int i = 0; i < 16; ++i) { const int r = rb + i; const int t = r % TPB; const int pos = t >= CTXL ? t - CTXL : 0; const int ii = lane & 31; const int p = (ii < 16) ? (pos / GRIDW) : (pos % GRIDW);
            rc[i] = tab[p * 8 + (ii & 7)]; rsn[i] = tab[512 + p * 8 + (ii & 7)]; }
        LOADS_ISSUED();
#pragma unroll
        for (int i = 0; i < 16; ++i) { const int r = rb + i; bf16_t* pr = proj + (size_t)r * INP;
            const float a0 = bflo(a[i].x), a1 = bfhi(a[i].x), a2 = bflo(a[i].y), a3 = bfhi(a[i].y), k0 = bflo(k[i]), k1 = bfhi(k[i]);
            const float s1 = wave_sum(a0 * a0 + a1 * a1 + a2 * a2 + a3 * a3), s2 = wave_sum(k0 * k0 + k1 * k1);
            const float r1 = rsqrtf(s1 * (1.f / QLORA) + EPS), r2 = rsqrtf(s2 * (1.f / KVLORA) + EPS);
            u32x2 ao; ao.x = pk2(a0 * r1, a1 * r1); ao.y = pk2(a2 * r1, a3 * r1);
            *(u32x2*)(pr + C_QA + lane * 4) = ao; *(unsigned*)(pr + C_KVA + lane * 2) = pk2(k0 * r2, k1 * r2);
            const int t = r % TPB;
            const float x = bf2f(xr[i]); const float partner = __shfl_xor(x, 8);
            float y = x;
            if (t >= CTXL) { const float rot = (lane & 8) ? partner : -partner; y = x * rc[i] + rot * rsn[i]; }
            if (lane < 32) krope[(size_t)r * DROPE + lane] = (bf16_t)f2bf(y); }
    }
}

constexpr int XCB_P = 264;
constexpr int HS_P = 264;
constexpr int LRU_XCB = 0, LRU_CARRY = 64 * XCB_P * 2  , LRU_HS = 36864;
template <int DIR, bool WANT_H> __device__ __forceinline__ void lru_scan4(const float (&a)[4], const float (&bq)[4], int lane, float& hm, float& ptile, float (&hout)[4]) {
    const int q = lane >> 4, qq = DIR ? 3 - q : q;
    float Pl[4], Hl[4]; float hh = 0.f, pp = 1.f;
#pragma unroll
    for (int ri = 0; ri < 4; ++ri) { const int reg = DIR ? 3 - ri : ri; hh = a[reg] * hh + bq[reg]; pp *= a[reg]; Pl[reg] = pp; Hl[reg] = hh; }
    float As = pp, Bs = hh;
    { const float A1 = DIR ? __shfl_down(As, 16) : __shfl_up(As, 16), B1 = DIR ? __shfl_down(Bs, 16) : __shfl_up(Bs, 16);
      if (qq >= 1) { Bs = As * B1 + Bs; As = A1 * As; } }
    { const float A2 = DIR ? __shfl_down(As, 32) : __shfl_up(As, 32), B2 = DIR ? __shfl_down(Bs, 32) : __shfl_up(Bs, 32);
      if (qq >= 2) { Bs = As * B2 + Bs; As = A2 * As; } }
    const int last_lane = (lane & 15) + (DIR ? 0 : 48);
    const float At = __shfl(As, last_lane), Bt = __shfl(Bs, last_lane);
    if (WANT_H) {
        float Ae = DIR ? __shfl_down(As, 16) : __shfl_up(As, 16), Be = DIR ? __shfl_down(Bs, 16) : __shfl_up(Bs, 16);
        if (qq == 0) { Ae = 1.f; Be = 0.f; }
        const float hin = Ae * hm + Be;
#pragma unroll
        for (int reg = 0; reg < 4; ++reg) hout[reg] = Hl[reg] + Pl[reg] * hin; }
    hm = At * hm + Bt; ptile *= At;
}
template <int PASS> __device__ __forceinline__ void lru_item(const Params& P, int l, int b, int j, unsigned char* lds) {
    const int tid = TIDX, lane = tid & 63, w = tid >> 6;
    bf16_t* xcb = (bf16_t*)(lds + LRU_XCB); float* carry = (float*)(lds + LRU_CARRY); bf16_t* hs = (bf16_t*)(lds + LRU_HS);
    const bf16_t* proj = (const bf16_t*)(P.ws + WS_PROJ); float* agg = (float*)(P.ws + WS_AGG); bf16_t* mix = (bf16_t*)(P.ws + WS_H);
    u32x4* cab = (u32x4*)(P.ws + WS_H2) + ((size_t)((b * 36 + j) * 8 + w)) * 16 * 64 + lane;
    const int h = w & 3, d = w >> 2, fr = lane & 15, fq = lane >> 4;
    const int t0 = j * 64;
    if (PASS == 1) {
        const bf16_t* Wl = (const bf16_t*)(P.ws + WS_WLRU) + (size_t)l * 2 * 2 * 4 * 4096;
        const float* cw = P.inp(13) + l * 4 * LRUW; const float* cb = P.inp(14) + l * LRUW;
        const int seq_lo = j < 4 ? 0 : CTXL, seq_hi = j < 4 ? CTXL : TPB;
        __syncthreads();
        {
            const int c = tid & 255, th = tid >> 8; const int ts = t0 + th * 32;
            const float w0 = cw[c], w1 = cw[LRUW + c], w2 = cw[2 * LRUW + c], w3 = cw[3 * LRUW + c], bb = cb[c];
            float xv[35]; unsigned short xraw[35];
#pragma unroll
            for (int i = 0; i < 35; ++i) { const int t = ts - 2 + i; const int tc = t < seq_lo ? seq_lo : (t >= seq_hi ? seq_hi - 1 : t);
                xraw[i] = proj[(size_t)(b * TPB + tc) * INP + C_XR + c]; }
            LOADS_ISSUED();
#pragma unroll
            for (int i = 0; i < 35; ++i) { const int t = ts - 2 + i; xv[i] = (t >= seq_lo && t < seq_hi) ? bf2f(xraw[i]) : 0.f; }
#pragma unroll
            for (int i = 0; i < 32; ++i) xcb[(th * 32 + i) * XCB_P + c] = (bf16_t)f2bf(w0 * xv[i] + w1 * xv[i + 1] + w2 * xv[i + 2] + w3 * xv[i + 3] + bb);
        }
        bf16x8_t BfA[4][2][2]; f32x4 lcA[4];
        { const f32x4* lc = (const f32x4*)(P.ws + WS_LRUC) + (l * 2 + d) * 256 + h * 64 + fr;
#pragma unroll
          for (int nt = 0; nt < 4; ++nt) { lcA[nt] = lc[nt * 16];
#pragma unroll
              for (int gate = 0; gate < 2; ++gate)
#pragma unroll
                  for (int ks = 0; ks < 2; ++ks) BfA[nt][gate][ks] = *(const bf16x8_t*)(Wl + ((size_t)(((d * 2 + gate) * 4 + h) * 64 + nt * 16 + fr)) * 64 + ks * 32 + fq * 8); } }
        __syncthreads();
#pragma unroll
        for (int nt = 0; nt < 4; ++nt) {
            const int c = h * 64 + nt * 16 + fr;
            const float br = lcA[nt].x, bi = lcA[nt].y, m8sp = lcA[nt].z;
            float hm = 0.f, ptile = 1.f;
#pragma unroll
            for (int mi = 0; mi < 4; ++mi) { const int mt = d ? 3 - mi : mi;
                f32x4 aR = (f32x4){0.f, 0.f, 0.f, 0.f}, aI = (f32x4){0.f, 0.f, 0.f, 0.f};
#pragma unroll
                for (int ks = 0; ks < 2; ++ks) { const bf16x8_t A = *(const bf16x8_t*)(xcb + (mt * 16 + fr) * XCB_P + h * 64 + ks * 32 + fq * 8);
                    aR = __builtin_amdgcn_mfma_f32_16x16x32_bf16(A, BfA[nt][0][ks], aR, 0, 0, 0);
                    aI = __builtin_amdgcn_mfma_f32_16x16x32_bf16(A, BfA[nt][1][ks], aI, 0, 0, 0); }
                float a[4], bq[4], la[4];
#pragma unroll
                for (int reg = 0; reg < 4; ++reg) { const float r = sigmoidf_(aR[reg] + br), ig = sigmoidf_(aI[reg] + bi); la[reg] = m8sp * r;
                    const float x2 = 2.f * la[reg]; const float em = -x2 * (1.f + x2 * (0.5f + x2 * (0.16666667f + x2 * (0.041666668f + x2 * (0.0083333338f + x2 * 0.0013888889f)))));
                    const float xcv = bf2f(xcb[(mt * 16 + fq * 4 + reg) * XCB_P + c]); bq[reg] = __builtin_amdgcn_sqrtf(fmaxf(em, 0.f)) * (ig * xcv); }
                u32x4 pkv; pkv.x = pk2(la[0], bq[0]); pkv.y = pk2(la[1], bq[1]); pkv.z = pk2(la[2], bq[2]); pkv.w = pk2(la[3], bq[3]);
                cab[(nt * 4 + mi) * 64] = pkv;
                const unsigned pw[4] = {pkv.x, pkv.y, pkv.z, pkv.w};
#pragma unroll
                for (int reg = 0; reg < 4; ++reg) { a[reg] = fexp_(bflo(pw[reg])); bq[reg] = bfhi(pw[reg]); }
                float hout[4];
                if (d == 0) lru_scan4<0, false>(a, bq, lane, hm, ptile, hout); else lru_scan4<1, false>(a, bq, lane, hm, ptile, hout);
            }
            if (fq == 0) { float* ag = agg + ((size_t)((b * 36 + j) * 2 + d)) * 512; ag[c] = ptile; ag[256 + c] = hm; }
        }
    } else {
        u32x4 cv[16];
#pragma unroll
        for (int i = 0; i < 16; ++i) cv[i] = cab[i * 64];
        __syncthreads();
        {
            const int c = tid & 255, dd = tid >> 8; float cvv = 0.f; const float* ab = agg + ((size_t)(b * 36) * 2 + dd) * 512 + c;
            float Ag[36], Bg[36];
#pragma unroll
            for (int k = 0; k < 36; ++k) { Ag[k] = ab[(size_t)k * 1024]; Bg[k] = ab[(size_t)k * 1024 + 256]; }
            LOADS_ISSUED();
            if (dd == 0) {
#pragma unroll
                for (int k = 0; k < 36; ++k) if (k < j) cvv = Ag[k] * cvv + Bg[k];
            } else {
#pragma unroll
                for (int k = 3; k >= 0; --k) if (j >= 4 || k > j) cvv = Ag[k] * cvv + Bg[k];
#pragma unroll
                for (int k = 35; k >= 4; --k) if (j >= 4 && k > j) cvv = Ag[k] * cvv + Bg[k];
            }
            carry[dd * 256 + c] = cvv;
        }
        __syncthreads();
#pragma unroll
        for (int nt = 0; nt < 4; ++nt) {
            const int c = h * 64 + nt * 16 + fr;
            float hm = carry[d * 256 + c], ptile = 1.f;
#pragma unroll
            for (int mi = 0; mi < 4; ++mi) { const int mt = d ? 3 - mi : mi;
                const u32x4 pkv = cv[nt * 4 + mi]; const unsigned pw[4] = {pkv.x, pkv.y, pkv.z, pkv.w};
                float a[4], bq[4], hout[4];
#pragma unroll
                for (int reg = 0; reg < 4; ++reg) { a[reg] = fexp_(bflo(pw[reg])); bq[reg] = bfhi(pw[reg]); }
                if (d == 0) lru_scan4<0, true>(a, bq, lane, hm, ptile, hout); else lru_scan4<1, true>(a, bq, lane, hm, ptile, hout);
#pragma unroll
                for (int reg = 0; reg < 4; ++reg) hs[(d * 64 + mt * 16 + fq * 4 + reg) * HS_P + c] = (bf16_t)f2bf(hout[reg]);
            }
        }
        __syncthreads();
        u32x2 gwv[8];
#pragma unroll
        for (int tt = 0; tt < 8; ++tt) gwv[tt] = *(const u32x2*)(proj + ((size_t)b * TPB + t0 + w * 8 + tt) * INP + C_GR + lane * 4);
#pragma unroll
        for (int tt = 0; tt < 8; ++tt) { const int t = w * 8 + tt; const size_t row = (size_t)b * TPB + t0 + t;
            const u32x2 h0 = *(const u32x2*)(hs + t * HS_P + lane * 4), h1 = *(const u32x2*)(hs + (64 + t) * HS_P + lane * 4);
            const f32x4 hv = (f32x4){bflo(h0.x) + bflo(h1.x), bfhi(h0.x) + bfhi(h1.x), bflo(h0.y) + bflo(h1.y), bfhi(h0.y) + bfhi(h1.y)};
            const u32x2 gw = gwv[tt];
            const float v0 = hv.x * geluf_(bflo(gw.x)), v1 = hv.y * geluf_(bfhi(gw.x)), v2 = hv.z * geluf_(bflo(gw.y)), v3 = hv.w * geluf_(bfhi(gw.y));
            const float ss = wave_sum(v0 * v0 + v1 * v1 + v2 * v2 + v3 * v3); const float rs = rsqrtf(ss * (1.f / LRUW) + EPS);
            u32x2 o; o.x = pk2(v0 * rs, v1 * rs); o.y = pk2(v2 * rs, v3 * rs);
            *(u32x2*)(mix + row * DM + 512 + lane * 4) = o; }
    }
}

constexpr int VGT_P = 136;
constexpr int SGT_P = 264;
__device__ __forceinline__ void sgu_item(const Params& P, int l, int b, int n, unsigned char* lds) {
    const int tid = TIDX, lane = tid & 63, w = tid >> 6, fr = lane & 15, fq = lane >> 4;
    bf16_t* vgT = (bf16_t*)lds; bf16_t* T = (bf16_t*)lds;
    const bf16_t* proj = (const bf16_t*)(P.ws + WS_PROJ); bf16_t* mix = (bf16_t*)(P.ws + WS_H);
    const int g = w & 3, ph = w >> 2;
    const bf16_t* Wg = (const bf16_t*)(P.ws + WS_WSGU) + (size_t)(l * 4 + g) * 16384;
    {
        const size_t row0 = (size_t)b * TPB + n * CHUNK;
        bf16x8_t Af[4][4];
#pragma unroll
        for (int mt = 0; mt < 4; ++mt)
#pragma unroll
            for (int ks = 0; ks < 4; ++ks) Af[mt][ks] = *(const bf16x8_t*)(Wg + (size_t)(ph * 64 + mt * 16 + fr) * 128 + ks * 32 + fq * 8);
        __syncthreads();
        {
            const int q = tid >> 2, c0 = (tid & 3) * 16;
            u32x4 rv[4][2];
#pragma unroll
            for (int gg = 0; gg < 4; ++gg) { const bf16_t* pv = proj + (row0 + q) * INP + C_SV + gg * 64 + c0; rv[gg][0] = *(const u32x4*)pv; rv[gg][1] = *(const u32x4*)(pv + 8); }
            f32x4 gnv[4][4]; { const float* gn = P.inp(20) + l * SGUW + c0;
#pragma unroll
              for (int gg = 0; gg < 4; ++gg)
#pragma unroll
                  for (int i4 = 0; i4 < 4; ++i4) gnv[gg][i4] = *(const f32x4*)(gn + gg * 64 + i4 * 4); }
            LOADS_ISSUED();
#pragma unroll
            for (int gg = 0; gg < 4; ++gg) {
                const u32x4 r0 = rv[gg][0], r1 = rv[gg][1];
                float v[16] = {bflo(r0.x), bfhi(r0.x), bflo(r0.y), bfhi(r0.y), bflo(r0.z), bfhi(r0.z), bflo(r0.w), bfhi(r0.w), bflo(r1.x), bfhi(r1.x), bflo(r1.y), bfhi(r1.y), bflo(r1.z), bfhi(r1.z), bflo(r1.w), bfhi(r1.w)};
                float ss = 0.f;
#pragma unroll
                for (int i = 0; i < 16; ++i) { v[i] = geluf_(v[i]); ss += v[i] * v[i]; }
                ss += __shfl_xor(ss, 1); ss += __shfl_xor(ss, 2);
                const float rs = rsqrtf(ss * (1.f / 64.f) + EPS);
#pragma unroll
                for (int i = 0; i < 16; ++i) vgT[(gg * 64 + c0 + i) * VGT_P + q] = (bf16_t)f2bf(v[i] * rs * gnv[gg][i >> 2][i & 3]);
            }
        }
        __syncthreads();
        f32x4 acc[4][4];
#pragma unroll
        for (int mt = 0; mt < 4; ++mt)
#pragma unroll
            for (int nt = 0; nt < 4; ++nt) acc[mt][nt] = (f32x4){0.f, 0.f, 0.f, 0.f};
#pragma unroll
        for (int ks = 0; ks < 4; ++ks) { bf16x8_t Bf[4];
#pragma unroll
            for (int nt = 0; nt < 4; ++nt) Bf[nt] = *(const bf16x8_t*)(vgT + (g * 64 + nt * 16 + fr) * VGT_P + ks * 32 + fq * 8);
#pragma unroll
            for (int mt = 0; mt < 4; ++mt)
#pragma unroll
                for (int nt = 0; nt < 4; ++nt) acc[mt][nt] = __builtin_amdgcn_mfma_f32_16x16x32_bf16(Af[mt][ks], Bf[nt], acc[mt][nt], 0, 0, 0); }
        __syncthreads();
#pragma unroll
        for (int mt = 0; mt < 4; ++mt)
#pragma unroll
            for (int reg = 0; reg < 4; ++reg) { const int p = ph * 64 + mt * 16 + fq * 4 + reg; const float bs = P.inp(22)[(l * 4 + g) * CHUNK + p];
#pragma unroll
                for (int nt = 0; nt < 4; ++nt) T[p * SGT_P + g * 64 + nt * 16 + fr] = (bf16_t)f2bf(acc[mt][nt][reg] + bs); }
        __syncthreads();
        u32x2 uwv[16];
#pragma unroll
        for (int tt = 0; tt < 16; ++tt) uwv[tt] = *(const u32x2*)(proj + (row0 + w * 16 + tt) * INP + C_SU + lane * 4);
#pragma unroll
        for (int tt = 0; tt < 16; ++tt) { const int t = w * 16 + tt; const size_t row = row0 + t;
            const u32x2 sw = *(const u32x2*)(T + t * SGT_P + lane * 4); const u32x2 uw = uwv[tt];
            const float v0 = geluf_(bflo(uw.x)) * bflo(sw.x), v1 = geluf_(bfhi(uw.x)) * bfhi(sw.x), v2 = geluf_(bflo(uw.y)) * bflo(sw.y), v3 = geluf_(bfhi(uw.y)) * bfhi(sw.y);
            const float ss = wave_sum(v0 * v0 + v1 * v1 + v2 * v2 + v3 * v3); const float rs = rsqrtf(ss * (1.f / SGUW) + EPS);
            u32x2 o; o.x = pk2(v0 * rs, v1 * rs); o.y = pk2(v2 * rs, v3 * rs);
            *(u32x2*)(mix + row * DM + 768 + lane * 4) = o; }
    }
}

__device__ __forceinline__ void stage_finalize(const Params& P, int bid, int nb, int skipctx) {
    const int lane = TIDX & 63, gw = bid * (NTHR / 64) + (TIDX >> 6), ngw = nb * (NTHR / 64);
    bf16_t* mix = (bf16_t*)(P.ws + WS_H);
    for (int r0 = gw * 4; r0 < NR; r0 += ngw * 4) {
        if (skipctx && (r0 % TPB) < CTXL) continue;
        u32x4 aw[4];
#pragma unroll
        for (int i = 0; i < 4; ++i) aw[i] = *(const u32x4*)(mix + (size_t)(r0 + i) * DM + lane * 8);
#pragma unroll
        for (int i = 0; i < 4; ++i) {
            float a[8] = {bflo(aw[i].x), bfhi(aw[i].x), bflo(aw[i].y), bfhi(aw[i].y), bflo(aw[i].z), bfhi(aw[i].z), bflo(aw[i].w), bfhi(aw[i].w)};
            float s2 = 0.f;
#pragma unroll
            for (int e = 0; e < 8; ++e) s2 += a[e] * a[e];
            s2 = wave_sum(s2); const float r2 = rsqrtf(s2 * (1.f / 512.f) + EPS);
            u32x4 o; o.x = pk2(a[0] * r2, a[1] * r2); o.y = pk2(a[2] * r2, a[3] * r2); o.z = pk2(a[4] * r2, a[5] * r2); o.w = pk2(a[6] * r2, a[7] * r2);
            *(u32x4*)(mix + (size_t)(r0 + i) * DM + lane * 8) = o; }
    }
}

namespace pg8 {
#define PG8_LAS __attribute__((address_space(3)))
typedef unsigned short bf16_t;
typedef short bf16x8 __attribute__((ext_vector_type(8)));
typedef float f32x4 __attribute__((ext_vector_type(4)));
typedef unsigned u32x4 __attribute__((ext_vector_type(4)));
constexpr int BM = 256, BK = 64, HALF = 128, HTB = HALF * BK * 2  , STAGE_BYTES = 8 * HTB, NXCD = 8, WGM = 4;

__host__ __device__ __forceinline__ int lds_byte(int r, int c) { const int st = (r >> 4) * 2 + (c >> 5), rr = r & 15, cc = c & 31, ob = rr * 64 + cc * 2; return st * 1024 + (ob ^ (((ob >> 9) & 1) << 5)); }
__host__ __device__ __forceinline__ void stage_rc(int b, int& R, int& C) { const int st = b / 1024, sb = b % 1024, swz = sb ^ (((sb >> 9) & 1) << 5); R = (st >> 1) * 16 + swz / 64; C = (st & 1) * 32 + (swz % 64) / 2; }
__host__ __device__ __forceinline__ int perm32(int rho) { const int n = rho >> 4, i = rho & 15; return 8 * (i >> 2) + 4 * n + (i & 3); }

struct Unit { int pm, pn; };
struct Gemm { const bf16_t* A; const bf16_t* Bt; int M, N, K, lda; int pn_split = 1 << 30, a_off2 = 0, pm_div9 = 0; };

struct StaticOrder {
    int nM, nN, nwg, G, c, skip, nsc, nss;
    __host__ __device__ void init(int M, int N, int G_, int c_, int skip_ = 0, int nsc_ = 0, int nss_ = 0) {
        skip = skip_; nM = skip == 1 ? 128 : (skip == 2 ? 16 : M / BM); nN = N / BM; nwg = nM * nN; G = G_; c = c_; nsc = nsc_; nss = nss_; }
    __host__ __device__ bool next(int i, Unit& u) const {
        const int R = i + (c < nsc ? nss : 0);
        const long L = (long)R * G + c - (long)nsc * (R < nss ? R + 1 : nss); if (L >= nwg) return false;
        int wgid = (int)L; { const int q = nwg / NXCD, r = nwg % NXCD, xcd = wgid % NXCD, off = wgid / NXCD; wgid = (xcd < r ? xcd * (q + 1) : r * (q + 1) + (xcd - r) * q) + off; }
        const int nig = WGM * nN, gid = wgid / nig, fm = gid * WGM, gsz = (nM - fm) < WGM ? (nM - fm) : WGM;
        u.pm = fm + ((wgid % nig) % gsz); u.pn = (wgid % nig) / gsz;
        if (skip == 1) u.pm = (u.pm >> 3) * 9 + 1 + (u.pm & 7); else if (skip == 2) u.pm = u.pm * 9;
        return true;
    }
    __device__ __forceinline__ void a_ready(const Unit&) const {}
    __device__ __forceinline__ void done(const Unit&) const {}
};

template <class Epi, class Sched, bool ALIGN_EPI = false, bool SP2 = false>
__device__ __forceinline__ void gemm_phase(PG8_LAS unsigned char* lds, const Gemm g, const Sched& S, const Epi& E) {
    const int tid = TIDX, wid = __builtin_amdgcn_readfirstlane(tid >> 6), lane = tid & 63, wr = wid >> 2, wc = wid & 3, fr = lane & 15, fq = lane >> 4;
    const int K = g.K, nt = K / BK;
    unsigned voffA[2], voffB[2];
#pragma unroll
    for (int i = 0; i < 2; ++i) { int R, C; stage_rc(tid * 16 + i * 8192, R, C); const int Rb = Epi::PERM ? ((R & ~31) + perm32(R & 31)) : R;
        voffA[i] = (unsigned)(R * g.lda + C) * 2u; voffB[i] = (unsigned)(Rb * K + C) * 2u; }
    const size_t kstep = (size_t)(BK * 2);
    const size_t hstepA = (size_t)HALF * g.lda * 2, hstepB = (size_t)HALF * K * 2;
    const size_t tstepA = 2 * hstepA, tstepB = 2 * hstepB;
    const unsigned ldsw = (unsigned)wid * 1024u;
    const int aoff = lds_byte(wr * 64 + fr, fq * 8), boff = lds_byte(wc * 32 + fr, fq * 8);
#define PG8_SA(b, h) (((b) * 2 + (h)) * HTB)
#define PG8_SB(b, h) ((4 + (b) * 2 + (h)) * HTB)
#define PG8_STAGE(bufoff, gbase, voff) do { _Pragma("unroll") for (int _i = 0; _i < 2; ++_i) \
        __builtin_amdgcn_global_load_lds((const unsigned*)((const char*)(gbase) + (voff)[_i]), (PG8_LAS unsigned*)(lds + (bufoff) + ldsw + _i * 8192), 16, 0, 0); } while (0)
#define PG8_LDA(dst, b, h) do { _Pragma("unroll") for (int m = 0; m < 4; ++m) _Pragma("unroll") for (int k = 0; k < 2; ++k) dst[m][k] = *(const PG8_LAS bf16x8*)(lds + PG8_SA(b, h) + aoff + m * 2048 + k * 1024); } while (0)
#define PG8_LDB(dst, b, h) do { _Pragma("unroll") for (int n = 0; n < 2; ++n) _Pragma("unroll") for (int k = 0; k < 2; ++k) dst[n][k] = *(const PG8_LAS bf16x8*)(lds + PG8_SB(b, h) + boff + n * 2048 + k * 1024); } while (0)
#define PG8_MMA(ai, bj, At, Bt) do { __builtin_amdgcn_s_setprio(1); _Pragma("unroll") for (int m = 0; m < 4; ++m) _Pragma("unroll") for (int n = 0; n < 2; ++n) _Pragma("unroll") for (int k = 0; k < 2; ++k) \
        acc[ai][bj][m][n] = __builtin_amdgcn_mfma_f32_16x16x32_bf16(Bt[n][k], At[m][k], acc[ai][bj][m][n], 0, 0, 0); __builtin_amdgcn_s_setprio(0); } while (0)
#define PG8_WAIT_V(n) asm volatile("s_waitcnt vmcnt(" #n ")" ::: "memory")
#define PG8_WAIT_L(n) asm volatile("s_waitcnt lgkmcnt(" #n ")" ::: "memory")
#define PG8_BAR __builtin_amdgcn_s_barrier()
#define PG8_SCHED __builtin_amdgcn_sched_barrier(0)
    Unit cur, nxt; int ui = 0;
    if (!S.next(0, cur)) return;
    f32x4 acc[2][2][4][2];
#pragma unroll
    for (int a = 0; a < 2; ++a)
#pragma unroll
        for (int b = 0; b < 2; ++b)
#pragma unroll
            for (int m = 0; m < 4; ++m)
#pragma unroll
                for (int n = 0; n < 2; ++n) acc[a][b][m][n] = (f32x4){0.f, 0.f, 0.f, 0.f};
    bf16x8 At[4][2], B0[2][2], B1[2][2];
    const char* cA = (const char*)g.A + (size_t)(g.pm_div9 ? cur.pm / 9 : cur.pm) * tstepA + (cur.pn >= g.pn_split ? (size_t)g.a_off2 * 2 : 0); const char* cB = (const char*)g.Bt + (size_t)cur.pn * tstepB;
    S.a_ready(cur);
    if constexpr (SP2) {
        PG8_STAGE(PG8_SB(0, 0), cB, voffB); PG8_STAGE(PG8_SB(0, 1), cB + hstepB, voffB); PG8_STAGE(PG8_SA(0, 0), cA, voffA); PG8_STAGE(PG8_SA(0, 1), cA + hstepA, voffA);
        if (wr == 1) PG8_BAR;
        PG8_WAIT_V(2); PG8_BAR;
        PG8_STAGE(PG8_SB(1, 0), cB + kstep, voffB); PG8_STAGE(PG8_SA(1, 0), cA + kstep, voffA); PG8_STAGE(PG8_SB(1, 1), cB + hstepB + kstep, voffB);
        PG8_WAIT_V(6); PG8_BAR;
    } else {
        PG8_STAGE(PG8_SB(0, 0), cB, voffB); PG8_STAGE(PG8_SA(0, 0), cA, voffA); PG8_STAGE(PG8_SB(0, 1), cB + hstepB, voffB); PG8_STAGE(PG8_SA(0, 1), cA + hstepA, voffA);
        if (wr == 1) PG8_BAR;
        PG8_WAIT_V(4); PG8_BAR;
        PG8_STAGE(PG8_SB(1, 0), cB + kstep, voffB); PG8_STAGE(PG8_SA(1, 0), cA + kstep, voffA); PG8_STAGE(PG8_SB(1, 1), cB + hstepB + kstep, voffB);
        PG8_WAIT_V(6); PG8_BAR;
    }
    for (;;) {
        const bool has_next = S.next(ui + 1, nxt);
        const char* nA = has_next ? (const char*)g.A + (size_t)(g.pm_div9 ? nxt.pm / 9 : nxt.pm) * tstepA + (nxt.pn >= g.pn_split ? (size_t)g.a_off2 * 2 : 0) : cA; const char* nB = has_next ? (const char*)g.Bt + (size_t)nxt.pn * tstepB : cB;
        for (int t = 0; t < nt; t += 2) {
            const bool last = (t == nt - 2);
            const char* a1 = cA + (size_t)(t + 1) * kstep;
            const char* a2 = last ? nA : cA + (size_t)(t + 2) * kstep; const char* b2 = last ? nB : cB + (size_t)(t + 2) * kstep;
            const char* a3 = a2 + kstep; const char* b3 = b2 + kstep;
            if (last && has_next) S.a_ready(nxt);
            if constexpr (SP2) {
            PG8_LDB(B0, 0, 0); PG8_LDB(B1, 0, 1); PG8_SCHED; PG8_LDA(At, 0, 0); PG8_STAGE(PG8_SA(1, 1), a1 + hstepA, voffA);
            PG8_WAIT_V(8); PG8_WAIT_L(0); PG8_BAR; PG8_MMA(0, 0, At, B0); PG8_MMA(0, 1, At, B1); PG8_BAR; PG8_SCHED;
            PG8_LDA(At, 0, 1); PG8_STAGE(PG8_SB(0, 0), b2, voffB); PG8_STAGE(PG8_SB(0, 1), b2 + hstepB, voffB); PG8_STAGE(PG8_SA(0, 0), a2, voffA);
            PG8_WAIT_V(8); PG8_WAIT_L(0); PG8_BAR; PG8_MMA(1, 0, At, B0); PG8_MMA(1, 1, At, B1); PG8_BAR; PG8_SCHED;
            PG8_LDB(B0, 1, 0); PG8_LDB(B1, 1, 1); PG8_SCHED; PG8_LDA(At, 1, 0); PG8_STAGE(PG8_SA(0, 1), a2 + hstepA, voffA);
            PG8_WAIT_V(8); PG8_WAIT_L(0); PG8_BAR; PG8_MMA(0, 0, At, B0); PG8_MMA(0, 1, At, B1); PG8_BAR; PG8_SCHED;
            PG8_LDA(At, 1, 1); PG8_STAGE(PG8_SB(1, 0), b3, voffB); PG8_STAGE(PG8_SB(1, 1), b3 + hstepB, voffB); PG8_STAGE(PG8_SA(1, 0), a3, voffA);
            PG8_WAIT_V(8); PG8_WAIT_L(0); PG8_BAR; PG8_MMA(1, 0, At, B0); PG8_MMA(1, 1, At, B1); PG8_BAR; PG8_SCHED;
            } else {
            PG8_LDB(B0, 0, 0); PG8_SCHED; PG8_LDA(At, 0, 0); PG8_STAGE(PG8_SA(1, 1), a1 + hstepA, voffA);
            PG8_WAIT_L(8); PG8_BAR; PG8_WAIT_L(0); PG8_MMA(0, 0, At, B0); PG8_BAR; PG8_SCHED;
            PG8_LDB(B1, 0, 1); PG8_STAGE(PG8_SB(0, 0), b2, voffB);
            PG8_BAR; PG8_WAIT_L(0); PG8_MMA(0, 1, At, B1); PG8_BAR;
            PG8_LDA(At, 0, 1); PG8_STAGE(PG8_SA(0, 0), a2, voffA);
            PG8_BAR; PG8_WAIT_L(0); PG8_MMA(1, 0, At, B0); PG8_BAR; PG8_SCHED;
            PG8_STAGE(PG8_SB(0, 1), b2 + hstepB, voffB);
            PG8_WAIT_V(6); PG8_BAR; PG8_MMA(1, 1, At, B1); PG8_BAR;
            PG8_LDB(B0, 1, 0); PG8_SCHED; PG8_LDA(At, 1, 0); PG8_STAGE(PG8_SA(0, 1), a2 + hstepA, voffA);
            PG8_WAIT_L(8); PG8_BAR; PG8_WAIT_L(0); PG8_MMA(0, 0, At, B0); PG8_BAR; PG8_SCHED;
            PG8_LDB(B1, 1, 1); PG8_STAGE(PG8_SB(1, 0), b3, voffB);
            PG8_BAR; PG8_WAIT_L(0); PG8_MMA(0, 1, At, B1); PG8_BAR;
            PG8_LDA(At, 1, 1); PG8_STAGE(PG8_SA(1, 0), a3, voffA);
            PG8_BAR; PG8_WAIT_L(0); PG8_MMA(1, 0, At, B0); PG8_BAR; PG8_SCHED;
            PG8_STAGE(PG8_SB(1, 1), b3 + hstepB, voffB);
            PG8_WAIT_V(6); PG8_BAR; PG8_MMA(1, 1, At, B1); PG8_BAR;
            }
        }
        if constexpr (ALIGN_EPI) { if (wr == 0) PG8_BAR; }
        if constexpr (!Epi::AFTER_DRAIN) { E(acc, cur, wr, wc, fr, fq); S.done(cur); }
        if (!has_next) break;
#pragma unroll
        for (int a = 0; a < 2; ++a)
#pragma unroll
            for (int b = 0; b < 2; ++b)
#pragma unroll
                for (int m = 0; m < 4; ++m)
#pragma unroll
                    for (int n = 0; n < 2; ++n) acc[a][b][m][n] = (f32x4){0.f, 0.f, 0.f, 0.f};
        cur = nxt; cA = nA; cB = nB; ++ui;
        if constexpr (ALIGN_EPI) { if (wr == 1) PG8_BAR; }
    }
    PG8_WAIT_V(0);
    if constexpr (!ALIGN_EPI) { if (wr == 0) PG8_BAR; }
    PG8_BAR;
    if constexpr (Epi::AFTER_DRAIN) { E.fused(acc, cur, wr, wc, fr, fq, lds, wid, lane); S.done(cur); }
#undef PG8_SA
#undef PG8_SB
#undef PG8_STAGE
#undef PG8_LDA
#undef PG8_LDB
#undef PG8_MMA
#undef PG8_WAIT_V
#undef PG8_WAIT_L
#undef PG8_BAR
#undef PG8_SCHED
}
}

using pg8::Unit;
__device__ __forceinline__ unsigned cvt_pk_bf16(float lo, float hi) { unsigned r; asm volatile("v_cvt_pk_bf16_f32 %0, %1, %2" : "=v"(r) : "v"(lo), "v"(hi)); return r; }
struct EpiBf16S {
    static constexpr bool PERM = true, AFTER_DRAIN = false;
    bf16_t* O; int ldc; const float* rowscale;
    __device__ __forceinline__ void operator()(const pg8::f32x4 (&acc)[2][2][4][2], const Unit& u, int wr, int wc, int fr, int fq) const {
        { const int ln = TIDX & 63; fr = ln & 15; fq = ln >> 4; }
        const int row0 = u.pm * 256 + wr * 64 + fr, col0 = u.pn * 256 + wc * 32 + 8 * fq;
#pragma unroll
        for (int ai = 0; ai < 2; ++ai)
#pragma unroll
            for (int m = 0; m < 4; ++m) { const int r = row0 + ai * 128 + m * 16; const float s = rowscale ? rowscale[r] : 1.f; bf16_t* rowp = O + (size_t)r * ldc + col0;
#pragma unroll
                for (int bj = 0; bj < 2; ++bj) { const pg8::f32x4 v0 = acc[ai][bj][m][0] * s, v1 = acc[ai][bj][m][1] * s;
                    u32x4 w; w.x = cvt_pk_bf16(v0[0], v0[1]); w.y = cvt_pk_bf16(v0[2], v0[3]); w.z = cvt_pk_bf16(v1[0], v1[1]); w.w = cvt_pk_bf16(v1[2], v1[3]);
                    *(u32x4*)(rowp + bj * 128) = w; } }
    }
};
struct EpiQKV {
    static constexpr bool PERM = true, AFTER_DRAIN = false;
    bf16_t* Oq; bf16_t* Okv;
    __device__ __forceinline__ void operator()(const f32x4 (&acc)[2][2][4][2], const Unit& u, int wr, int wc, int fr, int fq) const {
        { const int ln = TIDX & 63; fr = ln & 15; fq = ln >> 4; }
        const bool isq = u.pn < 3; bf16_t* O = isq ? Oq : Okv; const int ldc = isq ? QW : KVW;
        const int row0 = u.pm * 256 + wr * 64 + fr, col0 = (isq ? u.pn : u.pn - 3) * 256 + wc * 32 + 8 * fq;
#pragma unroll
        for (int ai = 0; ai < 2; ++ai)
#pragma unroll
            for (int m = 0; m < 4; ++m) { bf16_t* rowp = O + (size_t)(row0 + ai * 128 + m * 16) * ldc + col0;
#pragma unroll
                for (int bj = 0; bj < 2; ++bj) { const f32x4 v0 = acc[ai][bj][m][0], v1 = acc[ai][bj][m][1];
                    u32x4 w; w.x = cvt_pk_bf16(v0[0], v0[1]); w.y = cvt_pk_bf16(v0[2], v0[3]); w.z = cvt_pk_bf16(v1[0], v1[1]); w.w = cvt_pk_bf16(v1[2], v1[3]);
                    *(u32x4*)(rowp + bj * 128) = w; } }
    }
};
struct EpiProj {
    static constexpr bool PERM = true, AFTER_DRAIN = false;
    bf16_t* O; const float* rowss; const float* shw  ;
    __device__ __forceinline__ void operator()(const f32x4 (&acc)[2][2][4][2], const Unit& u, int wr, int wc, int fr, int fq) const {
        { const int ln = TIDX & 63; fr = ln & 15; fq = ln >> 4; }
        const int bt = u.pm / 9, jt = u.pm - bt * 9; const int mr = jt == 0 ? 16 : bt;
        const int row0 = u.pm * 256 + wr * 64 + fr, col0 = u.pn * 256 + wc * 32 + 8 * fq;
        float rr[8];
#pragma unroll
        for (int i = 0; i < 8; ++i) rr[i] = rsqrtf(rowss[row0 + (i >> 2) * 128 + (i & 3) * 16] * (1.f / DM) + EPS);
#pragma unroll
        for (int bj = 0; bj < 2; ++bj) { const float* sp = shw + (size_t)mr * 7168 + col0 + bj * 128; const f32x4 b0 = *(const f32x4*)sp, b1 = *(const f32x4*)(sp + 4);
#pragma unroll
            for (int ai = 0; ai < 2; ++ai)
#pragma unroll
                for (int m = 0; m < 4; ++m) { const float s = rr[ai * 4 + m]; const f32x4 v0 = acc[ai][bj][m][0] * s + b0, v1 = acc[ai][bj][m][1] * s + b1;
                    u32x4 w; w.x = cvt_pk_bf16(v0[0], v0[1]); w.y = cvt_pk_bf16(v0[2], v0[3]); w.z = cvt_pk_bf16(v1[0], v1[1]); w.w = cvt_pk_bf16(v1[2], v1[3]);
                    *(u32x4*)(O + (size_t)(row0 + ai * 128 + m * 16) * INP + col0 + bj * 128) = w; }
            asm volatile("" ::: "memory"); }
    }
};
struct EpiRes2 {
    static constexpr bool PERM = true, AFTER_DRAIN = false;
    GAS1 float* out; GAS1 unsigned char* ws; int l, gch; const float* gs  ; bf16_t* XB; float* rowss; const float* rd_lat; const float* rd_ctx;
    __device__ __forceinline__ void operator()(const f32x4 (&acc)[2][2][4][2], const Unit& u, int wr, int wc, int fr, int fq) const {
        { const int ln = TIDX & 63; fr = ln & 15; fq = ln >> 4; }
        const int b = u.pm / 9, j = u.pm - b * 9; const bool isctx = (j == 0); const int mr = isctx ? 16 : b;
        float* res0 = isctx ? (float*)(ws + WS_CRES) + (size_t)(b * CTXL) * DM : (float*)(out + (size_t)(b * SEQ + (j - 1) * 256) * DM);
        const float* gate = (const float*)(ws + WS_MOD) + ((size_t)(l * 17 + mr)) * 6144 + gch * 1024;
        const int col0 = u.pn * 256 + wc * 32 + 8 * fq, rloc = wr * 64 + fr;
        const float* rd0 = rd_lat ? (isctx ? rd_ctx + (size_t)(b * CTXL) * DM : rd_lat + (size_t)(b * SEQ + (j - 1) * 256) * DM) : res0;
        float ss[8];
#pragma unroll
        for (int i = 0; i < 8; ++i) ss[i] = 0.f;
        u32x4 pk[2][2][4];
#pragma unroll
        for (int ai = 0; ai < 2; ++ai)
#pragma unroll
            for (int bj = 0; bj < 2; ++bj)
#pragma unroll
                for (int m = 0; m < 4; ++m) { const f32x4 a0 = acc[ai][bj][m][0], a1 = acc[ai][bj][m][1];
                    pk[ai][bj][m] = (u32x4){cvt_pk_bf16(a0.x, a0.y), cvt_pk_bf16(a0.z, a0.w), cvt_pk_bf16(a1.x, a1.y), cvt_pk_bf16(a1.z, a1.w)}; }
        asm volatile("" ::: "memory");
#pragma unroll
        for (int bj = 0; bj < 2; ++bj) { const int cc = col0 + bj * 128; const f32x4 g0 = *(const f32x4*)(gate + cc), g1 = *(const f32x4*)(gate + cc + 4); f32x4 s0 = g0, s1 = g1;
            if (gs) { s0 = *(const f32x4*)(gs + mr * 1024 + cc); s1 = *(const f32x4*)(gs + mr * 1024 + cc + 4); }
            f32x4 x0[8], x1[8];
#pragma unroll
            for (int i = 0; i < 8; ++i) { const float* pr = rd0 + (size_t)(rloc + (i >> 2) * 128 + (i & 3) * 16) * DM + cc; x0[i] = *(const f32x4*)pr; x1[i] = *(const f32x4*)(pr + 4); }
            LOADS_ISSUED();
#pragma unroll
            for (int ai = 0; ai < 2; ++ai)
#pragma unroll
                for (int m = 0; m < 4; ++m) { const int rl = rloc + ai * 128 + m * 16; float* p = res0 + (size_t)rl * DM + cc; const u32x4 q = pk[ai][bj][m];
                    f32x4 o0 = x0[ai * 4 + m], o1 = x1[ai * 4 + m];
                    o0 += g0 * (f32x4){bflo(q.x), bfhi(q.x), bflo(q.y), bfhi(q.y)}; o1 += g1 * (f32x4){bflo(q.z), bfhi(q.z), bflo(q.w), bfhi(q.w)}; *(f32x4*)p = o0; *(f32x4*)(p + 4) = o1;
                    if (gs) { ss[ai * 4 + m] += (o0.x * o0.x + o0.y * o0.y + o0.z * o0.z + o0.w * o0.w) + (o1.x * o1.x + o1.y * o1.y + o1.z * o1.z + o1.w * o1.w);
                        const f32x4 y0 = o0 * s0, y1 = o1 * s1; u32x4 w; w.x = cvt_pk_bf16(y0.x, y0.y); w.y = cvt_pk_bf16(y0.z, y0.w); w.z = cvt_pk_bf16(y1.x, y1.y); w.w = cvt_pk_bf16(y1.z, y1.w);
                        *(u32x4*)(XB + (size_t)(u.pm * 256 + rl) * DM + cc) = w; } }
            asm volatile("" ::: "memory"); }
        if (gs) {
#pragma unroll
            for (int i = 0; i < 8; ++i) { float t = ss[i]; t += __shfl_xor(t, 16); t += __shfl_xor(t, 32);
                if (fq == 0) atomicAdd(rowss + u.pm * 256 + rloc + (i >> 2) * 128 + (i & 3) * 16, t); } }
    }
};
struct EpiSwiglu2 {
    static constexpr bool PERM = true, AFTER_DRAIN = false;
    bf16_t* O; bf16_t* Octx; const float* rowss; const float* shw  ;
    __device__ __forceinline__ void operator()(const f32x4 (&acc)[2][2][4][2], const Unit& u, int wr, int wc, int fr, int fq) const {
        { const int ln = TIDX & 63; fr = ln & 15; fq = ln >> 4; }
        const int bt = u.pm / 9, jt = u.pm - bt * 9; const int mr = jt == 0 ? 16 : bt;
        const int row0 = u.pm * 256 + wr * 64 + fr, col0 = u.pn * 128 + wc * 32 + 8 * fq;
        bf16_t* Ob = jt == 0 ? Octx + (size_t)(bt * 256 + wr * 64 + fr) * DFF : O + (size_t)row0 * DFF;
        const float* sp = shw + (size_t)mr * 7168 + u.pn * 256 + wc * 32 + 8 * fq;
        const f32x4 bg0 = *(const f32x4*)sp, bg1 = *(const f32x4*)(sp + 4), bu0 = *(const f32x4*)(sp + 128), bu1 = *(const f32x4*)(sp + 132);
#pragma unroll
        for (int ai = 0; ai < 2; ++ai)
#pragma unroll
            for (int m = 0; m < 4; ++m) { const int r = row0 + ai * 128 + m * 16; const float s = rsqrtf(rowss[r] * (1.f / DM) + EPS);
                const f32x4 g0 = acc[ai][0][m][0] * s + bg0, g1 = acc[ai][0][m][1] * s + bg1, u0 = acc[ai][1][m][0] * s + bu0, u1 = acc[ai][1][m][1] * s + bu1; float o[8];
#pragma unroll
                for (int i = 0; i < 4; ++i) { o[i] = g0[i] * u0[i] * __builtin_amdgcn_rcpf(1.f + __builtin_amdgcn_exp2f(-1.4426950408889634f * g0[i]));
                                              o[4 + i] = g1[i] * u1[i] * __builtin_amdgcn_rcpf(1.f + __builtin_amdgcn_exp2f(-1.4426950408889634f * g1[i])); }
                u32x4 w; w.x = cvt_pk_bf16(o[0], o[1]); w.y = cvt_pk_bf16(o[2], o[3]); w.z = cvt_pk_bf16(o[4], o[5]); w.w = cvt_pk_bf16(o[6], o[7]);
                *(u32x4*)(Ob + (size_t)(ai * 128 + m * 16) * DFF + col0) = w; }
    }
};

namespace attn {
using bf16x8 = __attribute__((ext_vector_type(8))) short;
using s16x4  = __attribute__((ext_vector_type(4))) short;
using f32x16 = __attribute__((ext_vector_type(16))) float;
constexpr int NW = 8, QBLK = 32, KVBLK = 64;
constexpr float SCALE = 0.10206207261596575f;
constexpr float THR = 8.f;
constexpr int SHM_K = 64 * 256, SHM_V = 64 * 64 * 2, NBUF = 3, SHM_ATTN = NBUF * SHM_V + NBUF * SHM_K + NW * 64 * 4;
#define KSWZ(row, colB) ((row) * 256 + ((colB) ^ (((row) & 7) << 4)))
#define SBAR() __builtin_amdgcn_sched_barrier(0)
__device__ __forceinline__ int crow(int r, int hi) { return (r & 3) + 8 * (r >> 2) + 4 * hi; }
__device__ __forceinline__ unsigned cvtpk(float lo, float hi) { unsigned r; asm volatile("v_cvt_pk_bf16_f32 %0, %1, %2" : "=v"(r) : "v"(lo), "v"(hi)); return r; }
constexpr float THRL = THR * 1.4426950408889634f;
__device__ __forceinline__ void partialSM(f32x16& p0, f32x16& p1, float& mhat, float& alpha, f32x16& negm, bool first) {
  float pmax = p0[0];
#pragma unroll
  for (int r = 1; r < 16; ++r) pmax = fmaxf(pmax, p0[r]);
#pragma unroll
  for (int r = 0; r < 16; ++r) pmax = fmaxf(pmax, p1[r]);
  { auto rr = __builtin_amdgcn_permlane32_swap(__float_as_uint(pmax), __float_as_uint(pmax), false, false);
    pmax = fmaxf(__uint_as_float(rr[0]), __uint_as_float(rr[1])); }
  alpha = 1.f;
  if (__builtin_expect(first || !__all(pmax <= THRL), 0)) {
    const float dl = first ? pmax : fmaxf(pmax, 0.f); mhat += dl;
#pragma unroll
    for (int r = 0; r < 16; ++r) { p0[r] -= dl; p1[r] -= dl; }
#pragma unroll
    for (int r = 0; r < 16; ++r) negm[r] = -mhat;
    if (!first) alpha = __builtin_amdgcn_exp2f(-dl);
  }
#pragma unroll
  for (int r = 0; r < 16; ++r) p0[r] = __builtin_amdgcn_exp2f(p0[r]);
}
__device__ __forceinline__ void finishSM(f32x16& p0, f32x16& p1, float alpha, float& l_reg, bf16x8& pa0, bf16x8& pa1, bf16x8& pa2, bf16x8& pa3) {
#pragma unroll
  for (int r = 0; r < 16; ++r) p1[r] = __builtin_amdgcn_exp2f(p1[r]);
  float ps = 0;
#pragma unroll
  for (int r = 0; r < 16; ++r) ps += p0[r];
#pragma unroll
  for (int r = 0; r < 16; ++r) ps += p1[r];
  { auto rr = __builtin_amdgcn_permlane32_swap(__float_as_uint(ps), __float_as_uint(ps), false, false);
    ps = __uint_as_float(rr[0]) + __uint_as_float(rr[1]); }
  l_reg = l_reg * alpha + ps;
#define PK4(P, BASE, OUT) do { unsigned a0 = cvtpk(P[BASE + 0], P[BASE + 1]), a1 = cvtpk(P[BASE + 2], P[BASE + 3]);   \
    unsigned b0 = cvtpk(P[BASE + 4], P[BASE + 5]), b1 = cvtpk(P[BASE + 6], P[BASE + 7]);                              \
    auto r0 = __builtin_amdgcn_permlane32_swap(a0, b0, false, false); auto r1 = __builtin_amdgcn_permlane32_swap(a1, b1, false, false); \
    u32x4 w = {r0[0], r1[0], r0[1], r1[1]}; OUT = *reinterpret_cast<bf16x8*>(&w); } while (0)
  PK4(p0, 0, pa0); PK4(p0, 8, pa1); PK4(p1, 0, pa2); PK4(p1, 8, pa3);
#undef PK4
}
__device__ __forceinline__ void qkt(f32x16& p0, f32x16& p1, const char* Ks, const bf16x8* qr, const f32x16& negm, int r32, int hi) {
  p0 = negm; p1 = negm;
#pragma unroll
  for (int d0 = 0; d0 < 6; ++d0) { int cb = (d0 * 16 + hi * 8) * 2;
    bf16x8 b0 = *reinterpret_cast<const bf16x8*>(Ks + KSWZ(r32, cb));
    bf16x8 b1 = *reinterpret_cast<const bf16x8*>(Ks + KSWZ(32 + r32, cb));
    p0 = __builtin_amdgcn_mfma_f32_32x32x16_bf16(b0, qr[d0], p0, 0, 0, 0);
    p1 = __builtin_amdgcn_mfma_f32_32x32x16_bf16(b1, qr[d0], p1, 0, 0, 0); }
}
__device__ __forceinline__ int v_st(int k, int c) { const int kk = (k & ~0xC) | ((k & 4) << 1) | ((k & 8) >> 1); return ((kk >> 3) * 2 + (c >> 5)) * 512 + ((kk & 7) * 32 + (c & 31)) * 2; }
__device__ __forceinline__ int v_rd_base(int lane) { return ((lane & 3) << 3) | (((lane >> 2) & 3) << 6) | (((lane >> 4) & 1) << 5) | (((lane >> 5) & 1) << 8); }
constexpr int v_rd_off(int d0, int ks, int half) { return d0 * 512 + ks * 2048 + half * 1024; }
template <int OFF> __device__ __forceinline__ s16x4 tr_read(int vb) {
  s16x4 r; asm volatile("ds_read_b64_tr_b16 %0, %1 offset:%2" : "=&v"(r) : "v"(vb), "i"(OFF) : "memory"); return r;
}
template <int D0> __device__ __forceinline__ void pv_one(f32x16& od, int vb, bf16x8 pa0, bf16x8 pa1, bf16x8 pa2, bf16x8 pa3) {
  const s16x4 l0 = tr_read<v_rd_off(D0, 0, 0)>(vb), h0 = tr_read<v_rd_off(D0, 0, 1)>(vb), l1 = tr_read<v_rd_off(D0, 1, 0)>(vb), h1 = tr_read<v_rd_off(D0, 1, 1)>(vb);
  const s16x4 l2 = tr_read<v_rd_off(D0, 2, 0)>(vb), h2 = tr_read<v_rd_off(D0, 2, 1)>(vb), l3 = tr_read<v_rd_off(D0, 3, 0)>(vb), h3 = tr_read<v_rd_off(D0, 3, 1)>(vb);
  asm volatile("s_waitcnt lgkmcnt(0)" ::: "memory"); SBAR();
#define PK(L, H) (bf16x8){L[0], L[1], L[2], L[3], H[0], H[1], H[2], H[3]}
  od = __builtin_amdgcn_mfma_f32_32x32x16_bf16(pa0, PK(l0, h0), od, 0, 0, 0);
  od = __builtin_amdgcn_mfma_f32_32x32x16_bf16(pa1, PK(l1, h1), od, 0, 0, 0);
  od = __builtin_amdgcn_mfma_f32_32x32x16_bf16(pa2, PK(l2, h2), od, 0, 0, 0);
  od = __builtin_amdgcn_mfma_f32_32x32x16_bf16(pa3, PK(l3, h3), od, 0, 0, 0);
#undef PK
}
__device__ __forceinline__ void pv_d0(f32x16* o, int vb, bf16x8 pa0, bf16x8 pa1, bf16x8 pa2, bf16x8 pa3) {
  pv_one<0>(o[0], vb, pa0, pa1, pa2, pa3); pv_one<1>(o[1], vb, pa0, pa1, pa2, pa3);
}
__device__ __forceinline__ void attn_unit(const bf16_t* __restrict__ Qb, const bf16_t* __restrict__ KVb, const bf16_t* __restrict__ KRb, bf16_t* __restrict__ Ob, int seq, char* lds,
                                          int pos0  , const float* __restrict__ tab) {
  const int tid = TIDX, wid = tid >> 6, lane = tid & 63, r32 = lane & 31, hi = lane >> 5;
  char* V_lds = lds; char* K_lds = lds + NBUF * SHM_V;
  float* ws = (float*)(lds + NBUF * SHM_V + NBUF * SHM_K) + wid * 64; float* li_l = ws; float* al_l = ws + 32;
  float mhat = 0.f, l_reg = 0; f32x16 o[2] = {}; bf16x8 qr[6]; f32x16 negm = {};
  const bf16_t* Qw = Qb + (long)(wid * QBLK + r32) * QW + hi * 8;
#pragma unroll
  for (int d0 = 0; d0 < 6; ++d0) qr[d0] = *reinterpret_cast<const bf16x8*>(Qw + d0 * 16);
  if (pos0 >= 0) {
    const int pos = pos0 + wid * QBLK + r32;
#pragma unroll
    for (int dd = 0; dd < 2; ++dd) { const int pp = dd == 0 ? (pos >> 6) : (pos & 63); const float* ct = tab + pp * 8; const float* st = tab + 512 + pp * 8;
      bf16x8 v = qr[4 + dd]; bf16x8 o;
#pragma unroll
      for (int j = 0; j < 8; ++j) { const float x = bf2f((unsigned short)v[j]); const float pr = __shfl_xor(x, 32); const float rot = hi ? pr : -pr;
        o[j] = (short)f2bf(x * ct[j] + rot * st[j]); }
      qr[4 + dd] = o; }
  }
  { constexpr float C = SCALE * 1.4426950408889634f;
#pragma unroll
    for (int d0 = 0; d0 < 6; ++d0) { bf16x8 v = qr[d0];
#pragma unroll
      for (int j = 0; j < 8; ++j) v[j] = (short)f2bf(bf2f((unsigned short)v[j]) * C);
      qr[d0] = v; } }
  const int sr = tid >> 4, c16 = tid & 15;
  const bool kfromkv = c16 < 8; const int kc = c16 < 12 ? c16 : 8;
  const bf16_t* kp0 = kfromkv ? KVb + (long)sr * KVW + kc * 8 : KRb + (long)sr * DROPE + (kc - 8) * 8;
  const long kstr = kfromkv ? KVW : DROPE;
  const bf16_t* vp0 = KVb + (long)sr * KVW + DNOPE + (c16 & 7) * 8;
  const int vst0 = v_st(sr, (c16 & 7) * 8), vst1 = v_st(32 + sr, (c16 & 7) * 8);
  const int kst0 = KSWZ(sr, kc * 16), kst1 = KSWZ(32 + sr, kc * 16);
  const bool kwr = c16 < 12, vwr = c16 < 8;
  const int vb0 = (int)(uintptr_t)V_lds + v_rd_base(lane);
  struct { bf16x8 vs0, vs1, ks0, ks1; } sr_[2];
#define SLOAD(i, k0) do { sr_[i].vs0 = *reinterpret_cast<const bf16x8*>(vp0 + (long)(k0) * KVW); sr_[i].vs1 = *reinterpret_cast<const bf16x8*>(vp0 + (long)((k0) + 32) * KVW); \
    sr_[i].ks0 = *reinterpret_cast<const bf16x8*>(kp0 + (long)(k0) * kstr); sr_[i].ks1 = *reinterpret_cast<const bf16x8*>(kp0 + (long)((k0) + 32) * kstr); } while (0)
#define SWRITE(b, i) do { if (vwr) { *(bf16x8*)(V_lds + (b) * SHM_V + vst0) = sr_[i].vs0; *(bf16x8*)(V_lds + (b) * SHM_V + vst1) = sr_[i].vs1; } \
    if (kwr) { *(bf16x8*)(K_lds + (b) * SHM_K + kst0) = sr_[i].ks0; *(bf16x8*)(K_lds + (b) * SHM_K + kst1) = sr_[i].ks1; } } while (0)
#define SWAIT() asm volatile("s_waitcnt vmcnt(4)" ::: "memory")
#define RESC(a) do { if (__any((a) < 1.f)) { if (hi == 0) al_l[r32] = (a); asm volatile("s_waitcnt lgkmcnt(0)" ::: "memory"); \
    _Pragma("unroll") for (int d = 0; d < 2; ++d) _Pragma("unroll") for (int r = 0; r < 16; ++r) o[d][r] *= al_l[crow(r, hi)]; } } while (0)
  f32x16 pA0, pA1, pB0, pB1; float alA, alB; bf16x8 pa0, pa1, pa2, pa3; const int NT = seq / KVBLK;
  constexpr int SE = 0, SO = 1;
  int i0 = 0, i1 = 1, i2 = 2;
#define ROT3() do { const int t_ = i0; i0 = i1; i1 = i2; i2 = t_; } while (0)
  SLOAD(SE, 0); asm volatile("s_waitcnt vmcnt(0)" ::: "memory"); SWRITE(0, SE); __syncthreads();
  qkt(pA0, pA1, K_lds, qr, negm, r32, hi); partialSM(pA0, pA1, mhat, alA, negm, true);
  SLOAD(SO, KVBLK); if (2 < NT) SLOAD(SE, 2 * KVBLK);
  SWAIT(); SWRITE(1, SO); __syncthreads();
  for (int j = 1; j + 1 < NT; j += 2) {
    SBAR(); qkt(pB0, pB1, K_lds + i1 * SHM_K, qr, negm, r32, hi);
    finishSM(pA0, pA1, alA, l_reg, pa0, pa1, pa2, pa3); SBAR();
    SLOAD(SO, (j + 2) * KVBLK); SBAR();
    pv_d0(o, vb0 + i0 * SHM_V, pa0, pa1, pa2, pa3); partialSM(pB0, pB1, mhat, alB, negm, false);
    SWAIT(); SWRITE(i2, SE);
    RESC(alB); __syncthreads(); ROT3();
    SBAR(); qkt(pA0, pA1, K_lds + i1 * SHM_K, qr, negm, r32, hi);
    finishSM(pB0, pB1, alB, l_reg, pa0, pa1, pa2, pa3); SBAR();
    if (j + 3 < NT) SLOAD(SE, (j + 3) * KVBLK); SBAR();
    pv_d0(o, vb0 + i0 * SHM_V, pa0, pa1, pa2, pa3); partialSM(pA0, pA1, mhat, alA, negm, false);
    SWAIT(); SWRITE(i2, SO);
    RESC(alA); __syncthreads(); ROT3();
  }
  SBAR(); qkt(pB0, pB1, K_lds + i1 * SHM_K, qr, negm, r32, hi);
  finishSM(pA0, pA1, alA, l_reg, pa0, pa1, pa2, pa3); SBAR();
  pv_d0(o, vb0 + i0 * SHM_V, pa0, pa1, pa2, pa3); partialSM(pB0, pB1, mhat, alB, negm, false);
  RESC(alB);
  finishSM(pB0, pB1, alB, l_reg, pa0, pa1, pa2, pa3); SBAR();
  pv_d0(o, vb0 + i1 * SHM_V, pa0, pa1, pa2, pa3);
#undef ROT3
  if (hi == 0) li_l[r32] = l_reg; asm volatile("s_waitcnt lgkmcnt(0)" ::: "memory");
  float rli[16];
#pragma unroll
  for (int r = 0; r < 16; ++r) rli[r] = __builtin_amdgcn_rcpf(li_l[crow(r, hi)]);
  bf16_t* Ow = Ob + (long)(wid * QBLK) * DM;
#pragma unroll
  for (int r = 0; r < 16; ++r) { const int orow = crow(r, hi);
#pragma unroll
    for (int d0 = 0; d0 < 2; ++d0) Ow[(long)orow * DM + d0 * 32 + r32] = (bf16_t)f2bf(o[d0][r] * rli[r]); }
  __syncthreads();
#undef SLOAD
#undef SWRITE
#undef SWAIT
#undef RESC
}
#undef KSWZ
#undef SBAR
}

__device__ __forceinline__ void phase_attn(const Params& P, bool with_ctx, int vcu, int G, unsigned char* lds) {
    const bf16_t* Q = (const bf16_t*)(P.ws + WS_Q); const bf16_t* KV = (const bf16_t*)(P.ws + WS_KV); const bf16_t* KR = (const bf16_t*)(P.ws + WS_KROPE); bf16_t* mix = (bf16_t*)(P.ws + WS_H);
    const int nu = NBATCH * NHEAD * 8 + (with_ctx ? NBATCH * NHEAD : 0);
    for (int uid = vcu; uid < nu; uid += G) {
        int b, h, row0, seq, pos0;
        if (uid < NBATCH * NHEAD * 8) { const int bh = uid >> 3, qb = uid & 7; b = bh >> 3; h = bh & 7; row0 = b * TPB + CTXL + qb * 256; seq = TPB; pos0 = qb * 256; }
        else { const int bh = uid - NBATCH * NHEAD * 8; b = bh >> 3; h = bh & 7; row0 = b * TPB; seq = CTXL; pos0 = -1; }
        attn::attn_unit(Q + (size_t)row0 * QW + h * DQK, KV + (size_t)(b * TPB) * KVW + h * 128, KR + (size_t)(b * TPB) * DROPE, mix + (size_t)row0 * DM + h * DV, seq, (char*)lds, pos0, (const float*)(P.ws + WS_ROPE));
    }
}

#define LAS __attribute__((address_space(3)))
__device__ __forceinline__ void phase_gemm_in(const Params& P, int l, LAS unsigned char* lds, int bid, int nb, int skip = 0, int nsc = 0, int nss = 0) {
    pg8::Gemm g{(const bf16_t*)(P.ws + WS_H), wptr(P, l, WO_WIN), NR, INP, DM, DM}; pg8::StaticOrder S; S.init(NR, INP, nb, bid, skip, nsc, nss);
    EpiProj E{(bf16_t*)(P.ws + WS_PROJ), (const float*)(P.ws + WS_ROWSS) + (size_t)(l * 2 + 0) * NR, (const float*)(P.ws + WS_SHW) + (size_t)l * 17 * 7168};
    pg8::gemm_phase<EpiProj, pg8::StaticOrder, true, true>(lds, g, S, E);
}
__device__ __forceinline__ void phase_gemm_qkv(const Params& P, int l, LAS unsigned char* lds, int bid, int nb) {
    int K = 256; asm volatile("" : "+s"(K));
    pg8::Gemm g{(const bf16_t*)(P.ws + WS_PROJ) + C_QA, wptr(P, l, WO_WQB), NR, QW + KVW, K, INP, 3, C_KVA - C_QA}; pg8::StaticOrder S; S.init(NR, QW + KVW, nb, bid);
    EpiQKV E{(bf16_t*)(P.ws + WS_Q), (bf16_t*)(P.ws + WS_KV)};
    pg8::gemm_phase<EpiQKV, pg8::StaticOrder, true, true>(lds, g, S, E);
}
__device__ __forceinline__ void phase_gemm_out(const Params& P, int l, LAS unsigned char* lds, int bid, int nb, int skip) {
    pg8::Gemm g{(const bf16_t*)(P.ws + WS_H), wptr(P, l, WO_WOUT), NR, DM, DM, DM}; pg8::StaticOrder S; S.init(NR, DM, nb, bid, skip);
    EpiRes2 E{P.out, P.ws, l, 2, (const float*)(P.ws + WS_GS) + (size_t)((l * 2 + 1) * 17) * 1024, (bf16_t*)(P.ws + WS_H2), (float*)(P.ws + WS_ROWSS) + (size_t)(l * 2 + 1) * NR, l == 0 ? P.inp(0) : nullptr, l == 0 ? P.inp(2) : nullptr};
    pg8::gemm_phase<EpiRes2, pg8::StaticOrder, true, true>(lds, g, S, E);
}
__device__ __forceinline__ void phase_gemm_ffi(const Params& P, int l, LAS unsigned char* lds, int bid, int nb, int skip, int nsc = 0, int nss = 0) {
    pg8::Gemm g{(const bf16_t*)(P.ws + WS_H2), wptr(P, l, WO_WFI), NR, 2 * DFF, DM, DM}; pg8::StaticOrder S; S.init(NR, 2 * DFF, nb, bid, skip, nsc, nss);
    EpiSwiglu2 E{(bf16_t*)(P.ws + WS_ACT), (bf16_t*)(P.ws + WS_ACTC), (const float*)(P.ws + WS_ROWSS) + (size_t)(l * 2 + 1) * NR, (const float*)(P.ws + WS_SHW) + (size_t)l * 17 * 7168 + 1536};
    pg8::gemm_phase<EpiSwiglu2, pg8::StaticOrder, true, true>(lds, g, S, E);
}
__device__ __forceinline__ void phase_gemm_ffo(const Params& P, int l, LAS unsigned char* lds, int bid, int nb, int skip) {
    pg8::Gemm g{skip == 2 ? (const bf16_t*)(P.ws + WS_ACTC) : (const bf16_t*)(P.ws + WS_ACT), wptr(P, l, WO_WFO), NR, DM, DFF, DFF}; g.pm_div9 = (skip == 2);
    pg8::StaticOrder S; S.init(NR, DM, nb, bid, skip);
    const bool nxt = l + 1 < DEPTH;
    EpiRes2 E{P.out, P.ws, l, 5, nxt ? (const float*)(P.ws + WS_GS) + (size_t)(((l + 1) * 2 + 0) * 17) * 1024 : nullptr, (bf16_t*)(P.ws + WS_H), (float*)(P.ws + WS_ROWSS) + (size_t)((l + 1) * 2 + 0) * NR, nullptr, nullptr};
    pg8::gemm_phase<EpiRes2, pg8::StaticOrder, true, true>(lds, g, S, E);
}

__device__ __forceinline__ void phase_small_b(const Params& P, int l, int last, int bid, int nb, unsigned char* lds) {
    const int n_lru = NBATCH * 36, n_sgu = last ? NBATCH * 16 : NBATCH * 18, n_rs = NR / 128;
#pragma unroll 1
    for (int it = bid; it < n_lru + n_sgu + n_rs; it += nb) {
        if (it < n_lru) lru_item<1>(P, l, it / 36, it % 36, lds);
        else if (it < n_lru + n_sgu) { const int k = it - n_lru; if (last) sgu_item(P, l, k >> 4, 2 + (k & 15), lds); else sgu_item(P, l, k / 18, k % 18, lds); }
        else rowstat_item(P, it - n_lru - n_sgu);
    }
}
__device__ __forceinline__ void phase_lru2(const Params& P, int l, int last, int bid, int nb, unsigned char* lds) {
    const int n = last ? NBATCH * 32 : NBATCH * 36;
#pragma unroll 1
    for (int it = bid; it < n; it += nb) { if (last) lru_item<2>(P, l, it >> 5, 4 + (it & 31), lds); else lru_item<2>(P, l, it / 36, it % 36, lds); }
}

#define XB_TMO      128
#define XB_XCNT(j)  (256  + 64 * (j))
#define XB_XSUB(j)  (1280 + 64 * (j))
#define XB_XGEN(j)  (2304 + 64 * (j))
#define XB_TOP      3328
#define XB_TOPGEN   3392
#define XCD_BAR_WORDS 3456
#define XB_SPIN_CAP (1u << 22)
constexpr int CW_BAR = 4096;
__device__ __forceinline__ unsigned xb_ld(unsigned* p)              { return __hip_atomic_load(p, __ATOMIC_RELAXED, __HIP_MEMORY_SCOPE_AGENT); }
__device__ __forceinline__ unsigned xb_add(unsigned* p, unsigned v) { return __hip_atomic_fetch_add(p, v, __ATOMIC_RELAXED, __HIP_MEMORY_SCOPE_AGENT); }
__device__ __forceinline__ unsigned xb_xcc_id() { return (unsigned)__builtin_amdgcn_s_getreg((3 << 11) | 20) & 0xFu; }
#define XB_SPIN(cond, bar) do { unsigned _sp = 0; while (cond) { __builtin_amdgcn_s_sleep(1); \
    if ((++_sp & 255u) == 0u) { if (xb_ld(&(bar)[XB_TMO])) break; if (_sp > XB_SPIN_CAP) { atomicAdd(&(bar)[XB_TMO], 1u); break; } } } } while (0)
struct XcdBarrier { unsigned* bar; unsigned x; volatile LAS unsigned* st; };
__device__ __forceinline__ XcdBarrier xcd_barrier_post(unsigned* bar, volatile LAS unsigned* st) {
    XcdBarrier b; b.bar = bar; b.x = xb_xcc_id(); b.st = st;
    if (threadIdx.x == 0) (void)xb_add(&bar[XB_XCNT(b.x)], 1u);
    return b;
}
__device__ __forceinline__ void xcd_barrier_complete(unsigned* bar, unsigned x, unsigned& nloc, unsigned& nx) {
    const unsigned G = gridDim.x * gridDim.y * gridDim.z;
    unsigned sum, cnt, mine, sp = 0u;
    for (;;) {
        sum = 0u; cnt = 0u; mine = 0u;
#pragma unroll
        for (unsigned j = 0; j < 16; ++j) { const unsigned c = xb_ld(&bar[XB_XCNT(j)]); sum += c; cnt += (c > 0u) ? 1u : 0u; mine = (j == x) ? c : mine; }
        if (sum == G) break;
        __builtin_amdgcn_s_sleep(1);
        if ((++sp & 255u) == 0u) { if (xb_ld(&bar[XB_TMO])) break; if (sp > XB_SPIN_CAP) { atomicAdd(&bar[XB_TMO], 1u); break; } }
    }
    nloc = mine > 0u ? mine : 1u; nx = cnt > 0u ? cnt : 1u;
}
__device__ __forceinline__ void xcd_barrier(const XcdBarrier& b) {
    asm volatile("s_waitcnt vmcnt(0)" ::: "memory");
    __syncthreads();
    if (threadIdx.x == 0) {
        unsigned* bar = b.bar; const unsigned bx_ = xb_xcc_id();
        __builtin_amdgcn_s_waitcnt(0);
        unsigned nloc = b.st[0], nx = b.st[1];
        if (nloc == 0u) { xcd_barrier_complete(bar, bx_, nloc, nx); b.st[0] = nloc; b.st[1] = nx; }
        const unsigned old = xb_add(&bar[XB_XSUB(bx_)], 1u);
        const unsigned gen = old / nloc;
        if (old + 1u == (gen + 1u) * nloc) {
            __builtin_amdgcn_fence(__ATOMIC_RELEASE, "agent");
            asm volatile("s_waitcnt vmcnt(0)" ::: "memory");
            const unsigned og = xb_add(&bar[XB_TOP], 1u);
            const unsigned tg = og / nx;
            if (og + 1u == (tg + 1u) * nx) xb_add(&bar[XB_TOPGEN], 1u);
            else XB_SPIN(xb_ld(&bar[XB_TOPGEN]) == tg, bar);
            __builtin_amdgcn_fence(__ATOMIC_ACQUIRE, "agent");
            xb_add(&bar[XB_XGEN(bx_)], 1u);
            asm volatile("s_waitcnt vmcnt(0)" ::: "memory");
        } else {
            XB_SPIN(xb_ld(&bar[XB_XGEN(bx_)]) == gen, bar);
            __builtin_amdgcn_fence(__ATOMIC_ACQUIRE, "agent");
            asm volatile("s_waitcnt vmcnt(0)" ::: "memory");
        }
    }
    __syncthreads();
}

constexpr int MISC_OFF = 131072 + 320, INTAB_OFF = 131072 + 2048;
__global__ void __launch_bounds__(NTHR, 2) mega_fwd(KArgs A) {
    extern __shared__ __attribute__((aligned(16))) unsigned char lds[];
    LAS unsigned char* lds3 = (LAS unsigned char*)lds;
    int bid = blockIdx.x, nb = gridDim.x;
    int vcu = (nb % 8 == 0) ? (bid % 8) * (nb / 8) + bid / 8 : bid;
    for (int u = threadIdx.x; u < (LDS_BYTES - 131072) / 4; u += NTHR) ((LAS unsigned*)(lds3 + 131072))[u] = 0u;
    __syncthreads();
    if (threadIdx.x < 28) ((LAS unsigned long long*)(lds3 + INTAB_OFF))[threadIdx.x] = (unsigned long long)A.in[threadIdx.x];
    __syncthreads();
    Params P; P.intab = (unsigned)(uintptr_t)(lds3 + INTAB_OFF); P.out = (GAS1 float*)A.out; P.ws = (GAS1 unsigned char*)A.ws;
    const XcdBarrier bar = xcd_barrier_post((unsigned*)(P.ws + WS_CTL) + CW_BAR, (volatile LAS unsigned*)(lds3 + MISC_OFF) + 8);
#define GBAR() xcd_barrier(bar)
    Params Q = P;
#define LND() asm volatile("" : "+s"(Q.ws), "+s"(Q.out), "+s"(bid), "+s"(nb), "+s"(vcu))
    LND(); stage_wprep(Q, bid, nb, lds);
    LND(); stage_mod(Q, bid, nb, lds);
    GBAR();
    LND(); stage_tables(Q, bid, nb, lds); LND(); stage_entry(Q, 0, 0, NBATCH * CTXL, bid, nb);
    GBAR();
    if (nb == 256) { LND(); phase_gemm_in(Q, 0, lds3, bid, nb, 2);
                     LND(); if (bid < 96) stage_entry(Q, 1, 0, 6400, bid, 96); else stage_entry(Q, 1, 6400, NBATCH * SEQ, bid - 96, nb - 96); }
    else { LND(); stage_entry(Q, 1, 0, NBATCH * SEQ, bid, nb); GBAR(); LND(); phase_gemm_in(Q, 0, lds3, bid, nb, 2); }
    GBAR();
    LND(); phase_gemm_in(Q, 0, lds3, bid, nb, 1);
    GBAR();
#pragma unroll 1
    for (int l = 0; l < DEPTH; ++l) {
        const int last = (l == DEPTH - 1) ? 1 : 0;
        LND(); phase_small_b(Q, l, last, bid, nb, lds);
        GBAR();
        LND(); phase_gemm_qkv(Q, l, lds3, bid, nb); LND(); phase_lru2(Q, l, last, bid, nb, lds);
        GBAR();
        LND(); phase_attn(Q, !last, vcu, nb, lds);
        GBAR();
        LND(); stage_finalize(Q, bid, nb, last);
        GBAR();
        if (last) {
            LND(); phase_gemm_out(Q, l, lds3, bid, nb, 1);
            GBAR();
            LND(); phase_gemm_ffi(Q, l, lds3, bid, nb, 1);
            GBAR();
            LND(); phase_gemm_ffo(Q, l, lds3, bid, nb, 1);
            GBAR();
        } else {
            LND(); phase_gemm_out(Q, l, lds3, bid, nb, 1);
            GBAR();
            LND(); phase_gemm_out(Q, l, lds3, bid, nb, 2); LND(); phase_gemm_ffi(Q, l, lds3, bid, nb, 1, 64, 2);
            GBAR();
            LND(); phase_gemm_ffi(Q, l, lds3, bid, nb, 2); LND(); phase_gemm_ffo(Q, l, lds3, bid, nb, 1);
            GBAR();
            LND(); phase_gemm_ffo(Q, l, lds3, bid, nb, 2); LND(); phase_gemm_in(Q, l + 1, lds3, bid, nb, 1, 64, 3);
            GBAR();
            LND(); phase_gemm_in(Q, l + 1, lds3, bid, nb, 2);
            GBAR();
        }
    }
    LND(); stage_norm(Q, 0, 3, bid, nb);

#undef LND
#undef GBAR
}

extern "C" void kernel_launch(void* const* d_in, const int* in_sizes, int n_in, void* d_out, int out_size, void* d_ws, size_t ws_size, hipStream_t stream) {
    static int ok = 0; static int mega_grid = 0;
    if (ok == 0) {
        if (n_in != 28 || out_size != NBATCH * SEQ * DM || ws_size < WS_END) { fprintf(stderr, "kernel_launch: unexpected shapes n_in %d out %d ws %zu\n", n_in, out_size, ws_size); ok = -1; return; }
        if (hipFuncSetAttribute((const void*)mega_fwd, hipFuncAttributeMaxDynamicSharedMemorySize, LDS_BYTES) != hipSuccess) { fprintf(stderr, "hipFuncSetAttribute(mega) failed\n"); ok = -1; return; }
        int dev = 0, cus = 0, per_cu = 0;
        (void)hipGetDevice(&dev); (void)hipDeviceGetAttribute(&cus, hipDeviceAttributeMultiprocessorCount, dev);
        if (hipOccupancyMaxActiveBlocksPerMultiprocessor(&per_cu, (const void*)mega_fwd, NTHR, LDS_BYTES) != hipSuccess || per_cu < 1) { fprintf(stderr, "occupancy query: %d blocks per CU\n", per_cu); ok = -1; return; }
        (void)hipGetLastError();
        mega_grid = cus;
        ok = 1;
    }
    if (ok < 0) return;
    KArgs P{};
    for (int i = 0; i < 28; ++i) P.in[i] = (const float*)d_in[i];
    P.out = (float*)d_out; P.ws = (unsigned char*)d_ws;
    (void)hipMemsetAsync((char*)d_ws + WS_CTL, 0, CTL_BYTES, stream);
    { void* args[] = {(void*)&P};
      hipError_t e = hipLaunchCooperativeKernel((const void*)mega_fwd, dim3(mega_grid), dim3(NTHR), args, LDS_BYTES, stream);
      if (e != hipSuccess) fprintf(stderr, "cooperative launch failed: %s (grid %d)\n", hipGetErrorString(e), mega_grid); }
}
```
